# Optimizing an MI355X kernel written in HIP

```python
import math
import jax, jax.numpy as jnp
from jax import lax
import numpy as np

D_MODEL = 1024
BATCH = 8
SEQ = 4096
DEPTH = 1

HEAD_DIM = 64
SWA_HEADS = 8
SWA_KV_HEADS = 2
SWA_WINDOW = 128
DSA_HEADS = 8
DSA_KV_RANK = 128
IDX_HEADS = 8
IDX_DIM = 64
IDX_TOPK_MAX = 256
DSA_QBLOCK = 128
REL_BUCKETS = 32
REL_MAX_DIST = 128
N_SELF_HEADS = SWA_HEADS + DSA_HEADS
MEM_LEN = 256
MEM_HEADS = 4
MEM_HEAD_DIM = D_MODEL // MEM_HEADS
D_FF = 4 * D_MODEL
DN_ALPHA = (2.0 * DEPTH) ** 0.25
DN_BETA = (8.0 * DEPTH) ** -0.25
LN_EPS = 1e-5
NEG_INF = -1e30
IN_SPLITS = (SWA_HEADS * HEAD_DIM,
             SWA_KV_HEADS * HEAD_DIM,
             SWA_KV_HEADS * HEAD_DIM,
             DSA_HEADS * HEAD_DIM,
             DSA_KV_RANK,
             IDX_HEADS * IDX_DIM,
             IDX_DIM,
             IDX_HEADS)
D_IN = sum(IN_SPLITS)
MIX_WIDTH = (SWA_HEADS + DSA_HEADS) * HEAD_DIM

kernel_name = "hybrid_swa_sink_dsa_deepnorm_block"


def layer_norm(x, g, b):
    xf = x.astype(jnp.float32)
    mu = jnp.mean(xf, axis=-1, keepdims=True)
    var = jnp.mean(jnp.square(xf - mu), axis=-1, keepdims=True)
    return ((xf - mu) * lax.rsqrt(var + LN_EPS) * g.astype(jnp.float32) + b.astype(jnp.float32)).astype(x.dtype)


def rms_norm(x, g):
    xf = x.astype(jnp.float32)
    ms = jnp.mean(jnp.square(xf), axis=-1, keepdims=True)
    return (xf * lax.rsqrt(ms + LN_EPS) * g.astype(jnp.float32)).astype(x.dtype)


def rel_bucket(dist):
    n = jnp.maximum(dist, 0)
    max_exact = REL_BUCKETS // 2
    nf = jnp.maximum(n, 1).astype(jnp.float32)
    large = max_exact + (jnp.log(nf / max_exact) / math.log(REL_MAX_DIST / max_exact)
                         * (REL_BUCKETS - max_exact)).astype(jnp.int32)
    large = jnp.minimum(large, REL_BUCKETS - 1)
    return jnp.where(n < max_exact, n, large)


def swa_sink_attention(q, k, v, sinks, rel_table):
    B, T, Hq, dh = q.shape
    W = SWA_WINDOW
    nb = T // W
    Hkv = SWA_KV_HEADS
    G = Hq // Hkv
    qb = q.reshape(B, nb, W, Hkv, G, dh)

    def band_blocks(z):
        zp = jnp.pad(z, ((0, 0), (W, 0), (0, 0), (0, 0)))
        prev = zp[:, :T].reshape(B, nb, W, Hkv, dh)
        cur = z.reshape(B, nb, W, Hkv, dh)
        return jnp.concatenate([prev, cur], axis=2)

    kb = band_blocks(k)
    vb = band_blocks(v)
    s = jnp.einsum('bnqkgd,bnskd->bnkgqs', qb, kb,
                   preferred_element_type=jnp.float32) * (dh ** -0.5)
    qi = jnp.arange(W)[:, None]
    si = jnp.arange(2 * W)[None, :]
    rel = qi + W - si
    band = (rel >= 0) & (rel < W)
    has_prev = (jnp.arange(nb) > 0)[:, None, None] | (si >= W)[None]
    valid = band[None] & has_prev
    bias = rel_table[rel_bucket(rel)].astype(jnp.float32)
    bias = jnp.transpose(bias, (2, 0, 1)).reshape(Hkv, G, W, 2 * W)
    logits = jnp.where(valid[None, :, None, None, :, :], s + bias, NEG_INF)
    sink = sinks.astype(jnp.float32).reshape(Hkv, G)[:, :, None, None]
    m = jnp.maximum(jnp.max(logits, axis=-1, keepdims=True), sink)
    p = jnp.exp(logits - m)
    denom = jnp.sum(p, axis=-1, keepdims=True) + jnp.exp(sink - m)
    o = jnp.einsum('bnkgqs,bnskd->bnqkgd', (p / denom).astype(v.dtype), vb)
    return o.reshape(B, T, Hq * dh)


def dsa_attention(q, c_kv, iq, ik, iw, w_uk, w_uv, rel_table):
    B, T, H, dh = q.shape
    topk = min(IDX_TOPK_MAX, T // 4)
    QB = DSA_QBLOCK
    nb = T // QB
    q_lat = jnp.einsum('bthd,hcd->bthc', q, w_uk) * (dh ** -0.5)
    key_pos = jnp.arange(T)

    def to_blocks(z):
        return jnp.moveaxis(z.reshape(B, nb, QB, *z.shape[2:]), 1, 0)

    def block(args):
        ql, iqb, iwb, n = args
        t = n * QB + jnp.arange(QB)
        dots = jnp.einsum('bqhd,bsd->bqhs', iqb, ik,
                          preferred_element_type=jnp.float32) * (IDX_DIM ** -0.5)
        score = jnp.einsum('bqh,bqhs->bqs', iwb.astype(jnp.float32), jax.nn.relu(dots))
        causal = key_pos[None, :] <= t[:, None]
        score = jnp.where(causal[None], score, NEG_INF)
        _, idx = lax.top_k(score, topk)
        ok = idx <= t[None, :, None]
        sel = jax.vmap(lambda c, i: c[i])(c_kv, idx)
        logits = jnp.einsum('bqhc,bqkc->bhqk', ql, sel, preferred_element_type=jnp.float32)
        bias = rel_table[rel_bucket(t[None, :, None] - idx)].astype(jnp.float32)
        logits = jnp.where(ok[:, None], logits + jnp.moveaxis(bias, 3, 1), NEG_INF)
        p = jax.nn.softmax(logits, axis=-1).astype(sel.dtype)
        o_lat = jnp.einsum('bhqk,bqkc->bqhc', p, sel)
        return jnp.einsum('bqhc,hcd->bqhd', o_lat, w_uv)

    out = lax.map(block, (to_blocks(q_lat), to_blocks(iq), to_blocks(iw), jnp.arange(nb)))
    return jnp.moveaxis(out, 0, 1).reshape(B, T, H * dh)


def memory_cross_attention(x, mem, wq, bq, wkv, bkv, wo, bo):
    B, T, _ = x.shape
    M = mem.shape[1]
    q = (x @ wq + bq).reshape(B, T, MEM_HEADS, MEM_HEAD_DIM)
    kv = mem @ wkv + bkv
    k, v = jnp.split(kv, 2, axis=-1)
    k = k.reshape(B, M, MEM_HEADS, MEM_HEAD_DIM)
    v = v.reshape(B, M, MEM_HEADS, MEM_HEAD_DIM)
    s = jnp.einsum('bthd,bmhd->bhtm', q, k, preferred_element_type=jnp.float32) * (MEM_HEAD_DIM ** -0.5)
    p = jax.nn.softmax(s, axis=-1).astype(v.dtype)
    o = jnp.einsum('bhtm,bmhd->bthd', p, v).reshape(B, T, D_MODEL)
    return o @ wo + bo


def setup_inputs(seed: int = 0) -> dict:
    key = jax.random.key(seed)
    ks = jax.random.split(key, 40)
    f32 = jnp.float32

    def w(k, shape, fan_in, scale=1.0):
        return jax.random.normal(k, shape, f32) * (fan_in ** -0.5) * scale

    def gain(k, shape):
        return 1.0 + 0.05 * jax.random.normal(k, shape, f32)

    def small(k, shape):
        return 0.01 * jax.random.normal(k, shape, f32)

    L = DEPTH
    return {
        "x": jax.random.normal(ks[0], (BATCH, SEQ, D_MODEL), f32),
        "mem": jax.random.normal(ks[1], (BATCH, MEM_LEN, D_MODEL), f32),
        "ln_emb_g": gain(ks[2], (D_MODEL,)),
        "ln_emb_b": small(ks[3], (D_MODEL,)),
        "w_in": w(ks[4], (L, D_MODEL, D_IN), D_MODEL),
        "b_in": small(ks[5], (L, D_IN)),
        "swa_sinks": 0.5 * jax.random.normal(ks[6], (L, SWA_HEADS), f32),
        "dsa_kv_norm_g": gain(ks[7], (L, DSA_KV_RANK)),
        "dsa_w_uk": w(ks[8], (L, DSA_HEADS, DSA_KV_RANK, HEAD_DIM), DSA_KV_RANK),
        "dsa_w_uv": w(ks[9], (L, DSA_HEADS, DSA_KV_RANK, HEAD_DIM), DSA_KV_RANK),
        "idx_k_ln_g": gain(ks[10], (L, IDX_DIM)),
        "idx_k_ln_b": small(ks[11], (L, IDX_DIM)),
        "rel_bias": 0.5 * jax.random.normal(ks[12], (REL_BUCKETS, N_SELF_HEADS), f32),
        "w_o": w(ks[13], (L, MIX_WIDTH, D_MODEL), MIX_WIDTH, DN_BETA),
        "b_o": small(ks[14], (L, D_MODEL)),
        "ln1_g": gain(ks[15], (L, D_MODEL)),
        "ln1_b": small(ks[16], (L, D_MODEL)),
        "xa_wq": w(ks[17], (L, D_MODEL, D_MODEL), D_MODEL),
        "xa_bq": small(ks[18], (L, D_MODEL)),
        "xa_wkv": w(ks[19], (L, D_MODEL, 2 * D_MODEL), D_MODEL),
        "xa_bkv": small(ks[20], (L, 2 * D_MODEL)),
        "xa_wo": w(ks[21], (L, D_MODEL, D_MODEL), D_MODEL, DN_BETA),
        "xa_bo": small(ks[22], (L, D_MODEL)),
        "ln2_g": gain(ks[23], (L, D_MODEL)),
        "ln2_b": small(ks[24], (L, D_MODEL)),
        "w_up": w(ks[25], (L, D_MODEL, D_FF), D_MODEL),
        "b_up": small(ks[26], (L, D_FF)),
        "w_down": w(ks[27], (L, D_FF, D_MODEL), D_FF, DN_BETA),
        "b_down": small(ks[28], (L, D_MODEL)),
        "ln3_g": gain(ks[29], (L, D_MODEL)),
        "ln3_b": small(ks[30], (L, D_MODEL)),
    }


def reference(x, mem, ln_emb_g, ln_emb_b, w_in, b_in, swa_sinks, dsa_kv_norm_g, dsa_w_uk, dsa_w_uv,
              idx_k_ln_g, idx_k_ln_b, rel_bias, w_o, b_o, ln1_g, ln1_b, xa_wq, xa_bq, xa_wkv, xa_bkv,
              xa_wo, xa_bo, ln2_g, ln2_b, w_up, b_up, w_down, b_down, ln3_g, ln3_b):
    B, T, _ = x.shape
    offsets = [int(o) for o in np.cumsum(IN_SPLITS)[:-1]]
    rel_a = rel_bias[:, :SWA_HEADS]
    rel_b = rel_bias[:, SWA_HEADS:]
    x = layer_norm(x, ln_emb_g, ln_emb_b)
    for l in range(DEPTH):
        h = x @ w_in[l] + b_in[l]
        qa, ka, va, qb, cb, iq, ik, iw = jnp.split(h, offsets, axis=-1)
        qa = qa.reshape(B, T, SWA_HEADS, HEAD_DIM)
        ka = ka.reshape(B, T, SWA_KV_HEADS, HEAD_DIM)
        va = va.reshape(B, T, SWA_KV_HEADS, HEAD_DIM)
        out_a = swa_sink_attention(qa, ka, va, swa_sinks[l], rel_a)
        qb = qb.reshape(B, T, DSA_HEADS, HEAD_DIM)
        cb = rms_norm(cb, dsa_kv_norm_g[l])
        iq = iq.reshape(B, T, IDX_HEADS, IDX_DIM)
        ik = layer_norm(ik, idx_k_ln_g[l], idx_k_ln_b[l])
        iw = iw * (IDX_HEADS ** -0.5)
        out_b = dsa_attention(qb, cb, iq, ik, iw, dsa_w_uk[l], dsa_w_uv[l], rel_b)
        mix = jnp.concatenate([out_a, out_b], axis=-1) @ w_o[l] + b_o[l]
        x = layer_norm(DN_ALPHA * x + mix, ln1_g[l], ln1_b[l])
        ca = memory_cross_attention(x, mem, xa_wq[l], xa_bq[l], xa_wkv[l], xa_bkv[l], xa_wo[l], xa_bo[l])
        x = layer_norm(DN_ALPHA * x + ca, ln2_g[l], ln2_b[l])
        f = jnp.square(jax.nn.relu(x @ w_up[l] + b_up[l])) @ w_down[l] + b_down[l]
        x = layer_norm(DN_ALPHA * x + f, ln3_g[l], ln3_b[l])
    return x
```

```cpp
#include <hip/hip_runtime.h>
#include <hip/hip_cooperative_groups.h>
#include <cstdio>
#include <cstdint>
namespace cg = cooperative_groups;

namespace pg8 {
#define PG8_LAS __attribute__((address_space(3)))
typedef unsigned short bf16_t;
typedef _Float16 bf16x8 __attribute__((ext_vector_type(8)));
typedef float f32x4 __attribute__((ext_vector_type(4)));
typedef unsigned u32x4 __attribute__((ext_vector_type(4)));
typedef unsigned u32x2 __attribute__((ext_vector_type(2)));
typedef float f32x2 __attribute__((ext_vector_type(2)));
typedef _Float16 f16x2 __attribute__((ext_vector_type(2)));
typedef _Float16 f16x4 __attribute__((ext_vector_type(4)));
constexpr int BM = 256, BK = 64, HALF = 128, HTB = HALF * BK * 2, STAGE_BYTES = 8 * HTB, NXCD = 8, WGM = 8;

__host__ __device__ __forceinline__ int lds_byte(int r, int c) { const int st = (r >> 4) * 2 + (c >> 5), rr = r & 15, cc = c & 31, ob = rr * 64 + cc * 2; return st * 1024 + (ob ^ (((ob >> 9) & 1) << 5)); }
__host__ __device__ __forceinline__ void stage_rc(int b, int& R, int& C) { const int st = b / 1024, sb = b % 1024, swz = sb ^ (((sb >> 9) & 1) << 5); R = (st >> 1) * 16 + swz / 64; C = (st & 1) * 32 + (swz % 64) / 2; }
__host__ __device__ __forceinline__ int perm32(int rho) { const int n = rho >> 4, i = rho & 15; return 8 * (i >> 2) + 4 * n + (i & 3); }

struct Unit { int pm, pn; };
struct Gemm { const bf16_t* A; const bf16_t* Bt; int M, N, K; };

struct StaticOrder {
    int nM, nN, nwg, G, c;
    __host__ __device__ void init(int M, int N, int G_, int c_) { nM = M / BM; nN = N / BM; nwg = nM * nN; G = G_; c = c_; }
    __host__ __device__ bool next(int i, Unit& u) const {
        const long L = (long)i * G + c; if (L >= nwg) return false;
        int wgid = (int)L; { const int q = nwg / NXCD, r = nwg % NXCD, xcd = wgid % NXCD, off = wgid / NXCD; wgid = (xcd < r ? xcd * (q + 1) : r * (q + 1) + (xcd - r) * q) + off; }
        const int nig = WGM * nN, gid = wgid / nig, fm = gid * WGM, gsz = (nM - fm) < WGM ? (nM - fm) : WGM;
        u.pm = fm + ((wgid % nig) % gsz); u.pn = (wgid % nig) / gsz; return true;
    }
    __device__ __forceinline__ void a_ready(const Unit&) const {}
    __device__ __forceinline__ void done(const Unit&) const {}
};

__device__ __forceinline__ unsigned pk_f16(float lo, float hi) { f32x2 v = {lo, hi}; f16x2 h = __builtin_convertvector(v, f16x2); return __builtin_bit_cast(unsigned, h); }

template <int ACT  > struct EpiF16 {
    static constexpr bool PERM = true, AFTER_DRAIN = false;
    bf16_t* O; int ldc; const float* bias;
    __device__ __forceinline__ void operator()(const f32x4 (&acc)[2][2][4][2], const Unit& u, int wr, int wc, int fr, int fq) const {
        const int row0 = u.pm * BM + wr * 64 + fr; const int col0 = u.pn * BM + wc * 32 + 8 * fq;
        f32x4 bv[2][2];
#pragma unroll
        for (int bj = 0; bj < 2; ++bj)
#pragma unroll
            for (int n = 0; n < 2; ++n) bv[bj][n] = *(const f32x4*)(bias + col0 + bj * HALF + 4 * n);
#pragma unroll
        for (int ai = 0; ai < 2; ++ai)
#pragma unroll
            for (int m = 0; m < 4; ++m) { bf16_t* rowp = O + (size_t)(row0 + ai * HALF + m * 16) * ldc + col0;
#pragma unroll
                for (int bj = 0; bj < 2; ++bj) { f32x4 v0 = acc[ai][bj][m][0] + bv[bj][0], v1 = acc[ai][bj][m][1] + bv[bj][1];
                    if (ACT == 2) {
#pragma unroll
                        for (int e = 0; e < 4; ++e) { const float a = fmaxf(v0[e], 0.f), b = fmaxf(v1[e], 0.f); v0[e] = a * a; v1[e] = b * b; } }
                    u32x4 w; w.x = pk_f16(v0[0], v0[1]); w.y = pk_f16(v0[2], v0[3]); w.z = pk_f16(v1[0], v1[1]); w.w = pk_f16(v1[2], v1[3]);
                    *(u32x4*)(rowp + bj * HALF) = w; } }
    }
};
struct EpiIn {
    static constexpr bool PERM = true, AFTER_DRAIN = false;
    bf16_t* O; int ldc; const float* bias; float* RAW; int rawt;
    __device__ __forceinline__ void operator()(const f32x4 (&acc)[2][2][4][2], const Unit& u, int wr, int wc, int fr, int fq) const {
        const int row0 = u.pm * BM + wr * 64 + fr; const int col0 = u.pn * BM + wc * 32 + 8 * fq;
        f32x4 bv[2][2];
#pragma unroll
        for (int bj = 0; bj < 2; ++bj)
#pragma unroll
            for (int n = 0; n < 2; ++n) bv[bj][n] = *(const f32x4*)(bias + col0 + bj * HALF + 4 * n);
        const bool raw = (u.pn == rawt);
#pragma unroll
        for (int ai = 0; ai < 2; ++ai)
#pragma unroll
            for (int m = 0; m < 4; ++m) { const size_t row = (size_t)(row0 + ai * HALF + m * 16); bf16_t* rowp = O + row * ldc + col0; float* rawp = RAW + row * 256 + wc * 32 + 8 * fq;
#pragma unroll
                for (int bj = 0; bj < 2; ++bj) { const f32x4 v0 = acc[ai][bj][m][0] + bv[bj][0], v1 = acc[ai][bj][m][1] + bv[bj][1];
                    if (raw) { *(f32x4*)(rawp + bj * HALF) = v0; *(f32x4*)(rawp + bj * HALF + 4) = v1; }
                    else { u32x4 w; w.x = pk_f16(v0[0], v0[1]); w.y = pk_f16(v0[2], v0[3]); w.z = pk_f16(v1[0], v1[1]); w.w = pk_f16(v1[2], v1[3]);
                        *(u32x4*)(rowp + bj * HALF) = w; } } }
    }
};
struct EpiKV {
    static constexpr bool PERM = true, AFTER_DRAIN = false;
    bf16_t* KM; bf16_t* VT; const float* bias;
    __device__ __forceinline__ void operator()(const f32x4 (&acc)[2][2][4][2], const Unit& u, int wr, int wc, int fr, int fq) const {
        const int col0 = u.pn * BM + wc * 32 + 8 * fq;
        f32x4 bv[2][2];
#pragma unroll
        for (int bj = 0; bj < 2; ++bj)
#pragma unroll
            for (int n = 0; n < 2; ++n) bv[bj][n] = *(const f32x4*)(bias + col0 + bj * HALF + 4 * n);
        const bool isv = u.pn >= 4;
#pragma unroll
        for (int ai = 0; ai < 2; ++ai)
#pragma unroll
            for (int m = 0; m < 4; ++m) { const int j = wr * 64 + fr + ai * HALF + m * 16;
#pragma unroll
                for (int bj = 0; bj < 2; ++bj) { const f32x4 v0 = acc[ai][bj][m][0] + bv[bj][0], v1 = acc[ai][bj][m][1] + bv[bj][1];
                    if (!isv) { u32x4 w; w.x = pk_f16(v0[0], v0[1]); w.y = pk_f16(v0[2], v0[3]); w.z = pk_f16(v1[0], v1[1]); w.w = pk_f16(v1[2], v1[3]);
                        *(u32x4*)(KM + (size_t)(u.pm * BM + j) * 1024 + col0 + bj * HALF) = w; }
                    else { _Float16* vt = (_Float16*)VT + ((size_t)(u.pm * 4 + (u.pn - 4)) * 256 + (wc * 32 + 8 * fq + bj * HALF)) * 256 + j;
#pragma unroll
                        for (int e = 0; e < 4; ++e) { vt[(size_t)e * 256] = (_Float16)v0[e]; vt[(size_t)(4 + e) * 256] = (_Float16)v1[e]; } } } }
    }
};
struct EpiPre {
    static constexpr bool PERM = false, AFTER_DRAIN = false;
    const bf16_t* base; float* out; int ldc; const float* bias; float alpha;
    __device__ __forceinline__ void operator()(const f32x4 (&acc)[2][2][4][2], const Unit& u, int wr, int wc, int fr, int fq) const {
        const int col0 = u.pn * BM + wc * 32 + 4 * fq;
        f32x4 bv[2][2];
#pragma unroll
        for (int bj = 0; bj < 2; ++bj)
#pragma unroll
            for (int n = 0; n < 2; ++n) bv[bj][n] = *(const f32x4*)(bias + col0 + bj * HALF + n * 16);
#pragma unroll
        for (int ai = 0; ai < 2; ++ai)
#pragma unroll
            for (int m = 0; m < 4; ++m) { const size_t off = (size_t)(u.pm * BM + ai * HALF + wr * 64 + m * 16 + fr) * ldc + col0;
#pragma unroll
                for (int bj = 0; bj < 2; ++bj)
#pragma unroll
                    for (int n = 0; n < 2; ++n) { const f16x4 bs = *(const f16x4*)(base + off + bj * HALF + n * 16);
                        f32x4 v = acc[ai][bj][m][n] + bv[bj][n];
#pragma unroll
                        for (int e = 0; e < 4; ++e) v[e] += alpha * (float)bs[e];
                        *(f32x4*)(out + off + bj * HALF + n * 16) = v; } }
    }
};

template <class Epi, class Sched, bool ALIGN_EPI = false, bool SP2 = false>
__device__ __forceinline__ void gemm_phase(PG8_LAS unsigned char* lds, const Gemm g, const Sched& S, const Epi& E) {
    int tid_ = threadIdx.x; asm volatile("" : "+v"(tid_));
    const int tid = tid_, wid = __builtin_amdgcn_readfirstlane(tid >> 6), lane = tid & 63, wr = wid >> 2, wc = wid & 3, fr = lane & 15, fq = lane >> 4;
    const int K = g.K, nt = K / BK;
    unsigned voffA[2], voffB[2];
#pragma unroll
    for (int i = 0; i < 2; ++i) { int R, C; stage_rc(tid * 16 + i * 8192, R, C); const int Rb = Epi::PERM ? ((R & ~31) + perm32(R & 31)) : R;
        voffA[i] = (unsigned)(R * K + C) * 2u; voffB[i] = (unsigned)(Rb * K + C) * 2u; }
    const size_t kstep = (size_t)(BK * 2);
    const size_t hstep = (size_t)HALF * K * 2;
    const size_t tstep = 2 * hstep;
    const unsigned ldsw = (unsigned)wid * 1024u;
    const int aoff = lds_byte(wr * 64 + fr, fq * 8), boff = lds_byte(wc * 32 + fr, fq * 8);
#define PG8_SA(b, h) (((b) * 2 + (h)) * HTB)
#define PG8_SB(b, h) ((4 + (b) * 2 + (h)) * HTB)
#define PG8_STAGE(bufoff, gbase, voff) do { _Pragma("unroll") for (int _i = 0; _i < 2; ++_i) \
        __builtin_amdgcn_global_load_lds((const unsigned*)((const char*)(gbase) + (voff)[_i]), (PG8_LAS unsigned*)(lds + (bufoff) + ldsw + _i * 8192), 16, 0, 0); } while (0)
#define PG8_LDA(dst, b, h) do { _Pragma("unroll") for (int m = 0; m < 4; ++m) _Pragma("unroll") for (int k = 0; k < 2; ++k) dst[m][k] = *(const PG8_LAS bf16x8*)(lds + PG8_SA(b, h) + aoff + m * 2048 + k * 1024); } while (0)
#define PG8_LDB(dst, b, h) do { _Pragma("unroll") for (int n = 0; n < 2; ++n) _Pragma("unroll") for (int k = 0; k < 2; ++k) dst[n][k] = *(const PG8_LAS bf16x8*)(lds + PG8_SB(b, h) + boff + n * 2048 + k * 1024); } while (0)
#define PG8_MMA(ai, bj, At, Bt) do { __builtin_amdgcn_s_setprio(1); _Pragma("unroll") for (int m = 0; m < 4; ++m) _Pragma("unroll") for (int n = 0; n < 2; ++n) _Pragma("unroll") for (int k = 0; k < 2; ++k) \
        acc[ai][bj][m][n] = __builtin_amdgcn_mfma_f32_16x16x32_f16(Bt[n][k], At[m][k], acc[ai][bj][m][n], 0, 0, 0); __builtin_amdgcn_s_setprio(0); } while (0)
#define PG8_WAIT_V(n) asm volatile("s_waitcnt vmcnt(" #n ")" ::: "memory")
#define PG8_WAIT_L(n) asm volatile("s_waitcnt lgkmcnt(" #n ")" ::: "memory")
#define PG8_BAR __builtin_amdgcn_s_barrier()
#define PG8_SCHED __builtin_amdgcn_sched_barrier(0)
    Unit cur, nxt; int ui = 0;
    if (!S.next(0, cur)) return;
    f32x4 acc[2][2][4][2];
#pragma unroll
    for (int a = 0; a < 2; ++a)
#pragma unroll
        for (int b = 0; b < 2; ++b)
#pragma unroll
            for (int m = 0; m < 4; ++m)
#pragma unroll
                for (int n = 0; n < 2; ++n) acc[a][b][m][n] = (f32x4){0.f, 0.f, 0.f, 0.f};
    bf16x8 At[4][2], B0[2][2], B1[2][2];
    const char* cA = (const char*)g.A + (size_t)cur.pm * tstep; const char* cB = (const char*)g.Bt + (size_t)cur.pn * tstep;
    S.a_ready(cur);
    if constexpr (SP2) {
        PG8_STAGE(PG8_SB(0, 0), cB, voffB); PG8_STAGE(PG8_SB(0, 1), cB + hstep, voffB); PG8_STAGE(PG8_SA(0, 0), cA, voffA); PG8_STAGE(PG8_SA(0, 1), cA + hstep, voffA);
        if (wr == 1) PG8_BAR;
        PG8_WAIT_V(2); PG8_BAR;
        PG8_STAGE(PG8_SB(1, 0), cB + kstep, voffB); PG8_STAGE(PG8_SA(1, 0), cA + kstep, voffA); PG8_STAGE(PG8_SB(1, 1), cB + hstep + kstep, voffB);
        PG8_WAIT_V(6); PG8_BAR;
    } else {
        PG8_STAGE(PG8_SB(0, 0), cB, voffB); PG8_STAGE(PG8_SA(0, 0), cA, voffA); PG8_STAGE(PG8_SB(0, 1), cB + hstep, voffB); PG8_STAGE(PG8_SA(0, 1), cA + hstep, voffA);
        if (wr == 1) PG8_BAR;
        PG8_WAIT_V(4); PG8_BAR;
        PG8_STAGE(PG8_SB(1, 0), cB + kstep, voffB); PG8_STAGE(PG8_SA(1, 0), cA + kstep, voffA); PG8_STAGE(PG8_SB(1, 1), cB + hstep + kstep, voffB);
        PG8_WAIT_V(6); PG8_BAR;
    }
    for (;;) {
        const bool has_next = S.next(ui + 1, nxt);
        const char* nA = has_next ? (const char*)g.A + (size_t)nxt.pm * tstep : cA; const char* nB = has_next ? (const char*)g.Bt + (size_t)nxt.pn * tstep : cB;
        for (int t = 0; t < nt; t += 2) {
            const bool last = (t == nt - 2);
            const char* a1 = cA + (size_t)(t + 1) * kstep;
            const char* a2 = last ? nA : cA + (size_t)(t + 2) * kstep; const char* b2 = last ? nB : cB + (size_t)(t + 2) * kstep;
            const char* a3 = a2 + kstep; const char* b3 = b2 + kstep;
            if (last && has_next) S.a_ready(nxt);
            if constexpr (SP2) {
            PG8_LDB(B0, 0, 0); PG8_LDB(B1, 0, 1); PG8_SCHED; PG8_LDA(At, 0, 0); PG8_STAGE(PG8_SA(1, 1), a1 + hstep, voffA);
            PG8_WAIT_V(8); PG8_WAIT_L(0); PG8_BAR; PG8_MMA(0, 0, At, B0); PG8_MMA(0, 1, At, B1); PG8_BAR; PG8_SCHED;
            PG8_LDA(At, 0, 1); PG8_STAGE(PG8_SB(0, 0), b2, voffB); PG8_STAGE(PG8_SB(0, 1), b2 + hstep, voffB); PG8_STAGE(PG8_SA(0, 0), a2, voffA);
            PG8_WAIT_V(8); PG8_WAIT_L(0); PG8_BAR; PG8_MMA(1, 0, At, B0); PG8_MMA(1, 1, At, B1); PG8_BAR; PG8_SCHED;
            PG8_LDB(B0, 1, 0); PG8_LDB(B1, 1, 1); PG8_SCHED; PG8_LDA(At, 1, 0); PG8_STAGE(PG8_SA(0, 1), a2 + hstep, voffA);
            PG8_WAIT_V(8); PG8_WAIT_L(0); PG8_BAR; PG8_MMA(0, 0, At, B0); PG8_MMA(0, 1, At, B1); PG8_BAR; PG8_SCHED;
            PG8_LDA(At, 1, 1); PG8_STAGE(PG8_SB(1, 0), b3, voffB); PG8_STAGE(PG8_SB(1, 1), b3 + hstep, voffB); PG8_STAGE(PG8_SA(1, 0), a3, voffA);
            PG8_WAIT_V(8); PG8_WAIT_L(0); PG8_BAR; PG8_MMA(1, 0, At, B0); PG8_MMA(1, 1, At, B1); PG8_BAR; PG8_SCHED;
            } else {
            PG8_LDB(B0, 0, 0); PG8_SCHED; PG8_LDA(At, 0, 0); PG8_STAGE(PG8_SA(1, 1), a1 + hstep, voffA);
            PG8_WAIT_L(8); PG8_BAR; PG8_WAIT_L(0); PG8_MMA(0, 0, At, B0); PG8_BAR; PG8_SCHED;
            PG8_LDB(B1, 0, 1); PG8_STAGE(PG8_SB(0, 0), b2, voffB);
            PG8_BAR; PG8_WAIT_L(0); PG8_MMA(0, 1, At, B1); PG8_BAR;
            PG8_LDA(At, 0, 1); PG8_STAGE(PG8_SA(0, 0), a2, voffA);
            PG8_BAR; PG8_WAIT_L(0); PG8_MMA(1, 0, At, B0); PG8_BAR; PG8_SCHED;
            PG8_STAGE(PG8_SB(0, 1), b2 + hstep, voffB);
            PG8_WAIT_V(6); PG8_BAR; PG8_MMA(1, 1, At, B1); PG8_BAR;
            PG8_LDB(B0, 1, 0); PG8_SCHED; PG8_LDA(At, 1, 0); PG8_STAGE(PG8_SA(0, 1), a2 + hstep, voffA);
            PG8_WAIT_L(8); PG8_BAR; PG8_WAIT_L(0); PG8_MMA(0, 0, At, B0); PG8_BAR; PG8_SCHED;
            PG8_LDB(B1, 1, 1); PG8_STAGE(PG8_SB(1, 0), b3, voffB);
            PG8_BAR; PG8_WAIT_L(0); PG8_MMA(0, 1, At, B1); PG8_BAR;
            PG8_LDA(At, 1, 1); PG8_STAGE(PG8_SA(1, 0), a3, voffA);
            PG8_BAR; PG8_WAIT_L(0); PG8_MMA(1, 0, At, B0); PG8_BAR; PG8_SCHED;
            PG8_STAGE(PG8_SB(1, 1), b3 + hstep, voffB);
            PG8_WAIT_V(6); PG8_BAR; PG8_MMA(1, 1, At, B1); PG8_BAR;
            }
        }
        if constexpr (ALIGN_EPI) { if (wr == 0) PG8_BAR; }
        if constexpr (!Epi::AFTER_DRAIN) { E(acc, cur, wr, wc, fr, fq); S.done(cur); }
        if (!has_next) break;
#pragma unroll
        for (int a = 0; a < 2; ++a)
#pragma unroll
            for (int b = 0; b < 2; ++b)
#pragma unroll
                for (int m = 0; m < 4; ++m)
#pragma unroll
                    for (int n = 0; n < 2; ++n) acc[a][b][m][n] = (f32x4){0.f, 0.f, 0.f, 0.f};
        cur = nxt; cA = nA; cB = nB; ++ui;
        if constexpr (ALIGN_EPI) { if (wr == 1) PG8_BAR; }
    }
    PG8_WAIT_V(0);
    if constexpr (!ALIGN_EPI) { if (wr == 0) PG8_BAR; }
    PG8_BAR;
    if constexpr (Epi::AFTER_DRAIN) { E.fused(acc, cur, wr, wc, fr, fq, lds, wid, lane); S.done(cur); }
#undef PG8_SA
#undef PG8_SB
#undef PG8_STAGE
#undef PG8_LDA
#undef PG8_LDB
#undef PG8_MMA
#undef PG8_WAIT_V
#undef PG8_WAIT_L
#undef PG8_BAR
#undef PG8_SCHED
}

}

constexpr int NB = 8, T = 4096, M = NB * T, D = 1024, DIN = 1992, NIN = 2560, MIXK = 1536, FF = 4096, MEML = 256, MROWS = NB * MEML;
constexpr int RAWT = 7;
constexpr float LN_EPS = 1e-5f, DN_ALPHA = 1.189207115002721f;
constexpr float NEG_INF = -1e30f;
constexpr size_t MiB = 1u << 20;
constexpr size_t WS_CTL = 0, CTL_BYTES = 1 * MiB;
constexpr size_t WS_RELB = 1 * MiB;
constexpr size_t WS_BINP = 1 * MiB + 65536;
constexpr size_t WS_BT_IN = 2 * MiB, WS_BT_O = 7 * MiB, WS_BT_Q = 10 * MiB, WS_BT_KV = 12 * MiB, WS_BT_WO = 16 * MiB, WS_BT_UP = 18 * MiB, WS_BT_DN = 26 * MiB;
constexpr size_t WS_MEM16 = 34 * MiB, WS_KVM = 38 * MiB;
constexpr size_t WS_X16 = 48 * MiB, WS_MIX = 112 * MiB, WS_H = 208 * MiB, WS_RAW = 368 * MiB, WS_SCR = 368 * MiB, WS_CB = 496 * MiB, WS_IK = 504 * MiB, WS_IW = 508 * MiB;
constexpr size_t WS_Q2 = 208 * MiB, WS_O2 = 272 * MiB, WS_HFF = 208 * MiB, WS_END = 510 * MiB;

typedef unsigned short h16;
typedef _Float16 f16;
typedef _Float16 f16x2 __attribute__((ext_vector_type(2)));
typedef _Float16 f16x4 __attribute__((ext_vector_type(4)));
typedef _Float16 f16x8 __attribute__((ext_vector_type(8)));
typedef float f32x4 __attribute__((ext_vector_type(4)));
typedef float f32x2 __attribute__((ext_vector_type(2)));
typedef unsigned u32x4 __attribute__((ext_vector_type(4)));
typedef unsigned u32x2 __attribute__((ext_vector_type(2)));
#define LAS __attribute__((address_space(3)))
typedef float f32x16 __attribute__((ext_vector_type(16)));
typedef short v4i16 __attribute__((ext_vector_type(4)));
typedef short v8i16 __attribute__((ext_vector_type(8)));
typedef unsigned short u16x8 __attribute__((ext_vector_type(8)));
__device__ __forceinline__ unsigned off_b(unsigned row, unsigned ch) { return 256u * row + 16u * (ch ^ (((row & 3) << 2) | ((row >> 2) & 3))); }
__device__ __forceinline__ unsigned tr_addr16(unsigned lane, unsigned c, unsigned t) { const unsigned g = lane >> 4, q = (lane & 15) >> 2, p = lane & 3; return off_b(8 * g + 4 * t + q, 2 * c + (p >> 1)) + 8 * (p & 1); }

__device__ const unsigned char REL_BUCKET[129] = {0, 1, 2, 3, 4, 5, 6, 7, 8, 9, 10, 11, 12, 13, 14, 15, 16, 16, 16, 17, 17, 18, 18, 18, 19, 19, 19, 20, 20, 20, 20, 21, 21, 21, 21, 22, 22, 22, 22, 22, 23, 23, 23, 23, 23, 23, 24, 24, 24, 24, 24, 24, 25, 25, 25, 25, 25, 25, 25, 26, 26, 26, 26, 26, 26, 26, 26, 27, 27, 27, 27, 27, 27, 27, 27, 27, 27, 28, 28, 28, 28, 28, 28, 28, 28, 28, 28, 29, 29, 29, 29, 29, 29, 29, 29, 29, 29, 29, 29, 30, 30, 30, 30, 30, 30, 30, 30, 30, 30, 30, 30, 30, 30, 31, 31, 31, 31, 31, 31, 31, 31, 31, 31, 31, 31, 31, 31, 31, 31};

struct Params { const float* in[31]; float* out; unsigned char* ws; };
enum { I_X = 0, I_MEM, I_LNE_G, I_LNE_B, I_W_IN, I_B_IN, I_SINKS, I_KVN_G, I_W_UK, I_W_UV, I_IKLN_G, I_IKLN_B, I_REL, I_W_O, I_B_O, I_LN1_G, I_LN1_B, I_WQ, I_BQ, I_WKV, I_BKV, I_WO, I_BO,
       I_LN2_G, I_LN2_B, I_W_UP, I_B_UP, I_W_DN, I_B_DN, I_LN3_G, I_LN3_B };

__device__ __forceinline__ float wave_sum(float v) {
#pragma unroll
    for (int o = 1; o < 64; o <<= 1) v += __shfl_xor(v, o);
    return v;
}
__device__ __forceinline__ float wave_max(float v) {
#pragma unroll
    for (int o = 1; o < 64; o <<= 1) v = fmaxf(v, __shfl_xor(v, o));
    return v;
}
__device__ __forceinline__ int wave_sum_i(int v) {
#pragma unroll
    for (int o = 1; o < 64; o <<= 1) v += __shfl_xor(v, o);
    return v;
}
__device__ __forceinline__ unsigned pk2h(float lo, float hi) { return pg8::pk_f16(lo, hi); }
__device__ __forceinline__ float ld_sc1(const float* p) { return __hip_atomic_load(p, __ATOMIC_RELAXED, __HIP_MEMORY_SCOPE_AGENT); }

__device__ __forceinline__ void p0_transpose_item(const float* W, int ldw, int col0, h16* WT, int ldd, int row0, int nblk, LAS float* scr, int item, int lane) {
    const int kb = item / nblk, nb = item % nblk, k0 = 64 * kb, n0 = 32 * nb;
#pragma unroll 8
    for (int i = 0; i < 32; ++i) { const int kk = 2 * i + (lane >> 5); scr[kk * 33 + (lane & 31)] = W[(size_t)(k0 + kk) * ldw + col0 + n0 + (lane & 31)]; }
    asm volatile("s_waitcnt lgkmcnt(0)" ::: "memory");
    const int c = lane & 7;
#pragma unroll
    for (int j = 0; j < 4; ++j) { const int n = (lane >> 3) + 8 * j; const LAS float* s = scr + (8 * c) * 33 + n;
        u32x4 o; o.x = pk2h(s[0 * 33], s[1 * 33]); o.y = pk2h(s[2 * 33], s[3 * 33]); o.z = pk2h(s[4 * 33], s[5 * 33]); o.w = pk2h(s[6 * 33], s[7 * 33]);
        *(u32x4*)(WT + (size_t)(row0 + n0 + n) * ldd + k0 + 8 * c) = o; }
    asm volatile("s_waitcnt lgkmcnt(0)" ::: "memory");
}

template <bool OUT16> __device__ __forceinline__ void ln_row(const float* xrow, const float* g, const float* b, void* orow, int lane) {
    const f32x4* xr = (const f32x4*)xrow + lane;
    f32x4 v[4]; float s = 0.f;
#pragma unroll
    for (int j = 0; j < 4; ++j) { v[j] = xr[64 * j]; s += (v[j].x + v[j].y) + (v[j].z + v[j].w); }
    const float mean = wave_sum(s) * (1.f / D); float s2 = 0.f;
#pragma unroll
    for (int j = 0; j < 4; ++j) { v[j] = v[j] - mean; s2 += (v[j].x * v[j].x + v[j].y * v[j].y) + (v[j].z * v[j].z + v[j].w * v[j].w); }
    const float rstd = 1.f / sqrtf(wave_sum(s2) * (1.f / D) + LN_EPS);
#pragma unroll
    for (int j = 0; j < 4; ++j) { const f32x4 gg = ((const f32x4*)g)[lane + 64 * j], bb = ((const f32x4*)b)[lane + 64 * j]; const f32x4 o = v[j] * rstd * gg + bb;
        if (OUT16) { u32x2 w; w.x = pk2h(o.x, o.y); w.y = pk2h(o.z, o.w); ((u32x2*)orow)[lane + 64 * j] = w; }
        else ((f32x4*)orow)[lane + 64 * j] = o; }
}

__device__ __forceinline__ unsigned mono_key(float f) { unsigned b = __float_as_uint(f); if (b == 0x80000000u) b = 0u; return b ^ ((unsigned)((int)b >> 31) | 0x80000000u); }
__device__ __forceinline__ int wave_sum_dpp(int c) {
    int x = c;
    x += __builtin_amdgcn_update_dpp(0, x, 0x111, 0xf, 0xf, false);
    x += __builtin_amdgcn_update_dpp(0, x, 0x112, 0xf, 0xf, false);
    x += __builtin_amdgcn_update_dpp(0, x, 0x114, 0xf, 0xf, false);
    x += __builtin_amdgcn_update_dpp(0, x, 0x118, 0xf, 0xf, false);
    x += __builtin_amdgcn_update_dpp(0, x, 0x142, 0xa, 0xf, false);
    x += __builtin_amdgcn_update_dpp(0, x, 0x143, 0xc, 0xf, false);
    return __builtin_amdgcn_readlane(x, 63);
}
__device__ __forceinline__ int count_ge(const unsigned (&u)[64], unsigned cand, int ngrp) {
    int c = 0;
#pragma unroll
    for (int gq = 0; gq < 4; ++gq) if (gq < ngrp) {
#pragma unroll
        for (int jj = 0; jj < 16; ++jj) c += __popcll(__ballot(u[gq * 16 + jj] >= cand)); }
    return c;
}
__device__ __forceinline__ int select_topk(const unsigned (&u)[64], int n, int ngrp, LAS unsigned short* idx, int lane) {
    unsigned th = 0u; int need = 0;
    if (n > 256) {
        unsigned lo = 0u; bool exact = false;
        for (int bit = 31; bit >= 0; --bit) {
            const unsigned cand = lo | (1u << bit); const int c = count_ge(u, cand, ngrp);
            if (c == 256) { th = cand - 1u; need = 0; exact = true; break; }
            if (c > 256) lo = cand;
        }
        if (!exact) { th = lo; need = 256 - count_ge(u, lo + 1u, ngrp); }
    }
    int base = 0, tie_seen = 0;
    const unsigned long long lt = (1ull << lane) - 1ull;
#pragma unroll
    for (int gq = 0; gq < 4; ++gq) if (gq < ngrp) {
#pragma unroll
        for (int jj = 0; jj < 16; ++jj) {
            const int j = gq * 16 + jj;
            const bool gt = u[j] > th; const bool eq = (need > 0) && (u[j] == th);
            const unsigned long long meq = __ballot(eq);
            const int eq_rank = tie_seen + __popcll(meq & lt);
            const bool sel = gt || (eq && eq_rank < need);
            const unsigned long long msel = __ballot(sel);
            const int pos = base + __popcll(msel & lt);
            if (sel) idx[pos] = (unsigned short)(64 * j + lane);
            base += __popcll(msel); tie_seen += __popcll(meq);
        } }
    return base;
}

#define XB_TMO      128
#define XB_XCNT(j)  (256  + 64 * (j))
#define XB_XSUB(j)  (1280 + 64 * (j))
#define XB_XGEN(j)  (2304 + 64 * (j))
#define XB_TOP      3328
#define XB_TOPGEN   3392
#define XCD_BAR_WORDS 3456
#define XB_SPIN_CAP (1u << 18)

__device__ __forceinline__ unsigned xb_ld(unsigned* p)              { return __hip_atomic_load(p, __ATOMIC_RELAXED, __HIP_MEMORY_SCOPE_AGENT); }
__device__ __forceinline__ unsigned xb_add(unsigned* p, unsigned v) { return __hip_atomic_fetch_add(p, v, __ATOMIC_RELAXED, __HIP_MEMORY_SCOPE_AGENT); }
__device__ __forceinline__ unsigned xb_xcc_id() { return (unsigned)__builtin_amdgcn_s_getreg((3 << 11) | 20) & 0xFu; }
#define XB_SPIN(cond, bar) do { unsigned _sp = 0; while (cond) { __builtin_amdgcn_s_sleep(1); \
    if ((++_sp & 255u) == 0u) { if (xb_ld(&(bar)[XB_TMO])) break; if (_sp > XB_SPIN_CAP) { atomicAdd(&(bar)[XB_TMO], 1u); break; } } } } while (0)

struct XcdBarrier {
    unsigned* bar; unsigned x;
    volatile LAS unsigned* st;
};

__device__ __forceinline__ XcdBarrier xcd_barrier_post(unsigned* bar, volatile LAS unsigned* st) {
    XcdBarrier b; b.bar = bar; b.x = xb_xcc_id(); b.st = st;
    if (threadIdx.x == 0) (void)xb_add(&bar[XB_XCNT(b.x)], 1u);
    return b;
}
__device__ __forceinline__ void xcd_barrier_complete(unsigned* bar, unsigned x, unsigned& nloc, unsigned& nx) {
    const unsigned G = gridDim.x * gridDim.y * gridDim.z;
    unsigned sum, cnt, mine, sp = 0u;
    for (;;) {
        sum = 0u; cnt = 0u; mine = 0u;
#pragma unroll
        for (unsigned j = 0; j < 16; ++j) { const unsigned c = xb_ld(&bar[XB_XCNT(j)]); sum += c; cnt += (c > 0u) ? 1u : 0u; mine = (j == x) ? c : mine; }
        if (sum == G) break;
        __builtin_amdgcn_s_sleep(1);
        if ((++sp & 255u) == 0u) { if (xb_ld(&bar[XB_TMO])) break; if (sp > XB_SPIN_CAP) { atomicAdd(&bar[XB_TMO], 1u); break; } }
    }
    nloc = mine > 0u ? mine : 1u; nx = cnt > 0u ? cnt : 1u;
}

__device__ __forceinline__ void xcd_barrier(const XcdBarrier& b) {
    asm volatile("s_waitcnt vmcnt(0)" ::: "memory");
    __syncthreads();
    if (threadIdx.x == 0) {
        unsigned* bar = b.bar;
        __builtin_amdgcn_s_waitcnt(0);
        unsigned nloc = b.st[0], nx = b.st[1];
        if (nloc == 0u) { xcd_barrier_complete(bar, b.x, nloc, nx); b.st[0] = nloc; b.st[1] = nx; }
        const unsigned old = xb_add(&bar[XB_XSUB(b.x)], 1u);
        const unsigned gen = old / nloc;
        if (old + 1u == (gen + 1u) * nloc) {
            __builtin_amdgcn_fence(__ATOMIC_RELEASE, "agent");
            asm volatile("s_waitcnt vmcnt(0)" ::: "memory");
            const unsigned og = xb_add(&bar[XB_TOP], 1u);
            const unsigned tg = og / nx;
            if (og + 1u == (tg + 1u) * nx) xb_add(&bar[XB_TOPGEN], 1u);
            else XB_SPIN(xb_ld(&bar[XB_TOPGEN]) == tg, bar);
            __builtin_amdgcn_fence(__ATOMIC_ACQUIRE, "agent");
            xb_add(&bar[XB_XGEN(b.x)], 1u);
            asm volatile("s_waitcnt vmcnt(0)" ::: "memory");
        } else {
            XB_SPIN(xb_ld(&bar[XB_XGEN(b.x)]) == gen, bar);
            __builtin_amdgcn_fence(__ATOMIC_ACQUIRE, "agent");
            asm volatile("s_waitcnt vmcnt(0)" ::: "memory");
        }
    }
    __syncthreads();
}

#ifndef PHM
#define PHM 0xFFFF
#endif
constexpr int NWAVES = 8, NTHREADS = 512;
constexpr int LDS_BYTES = 147456;

__global__ void __launch_bounds__(NTHREADS, 2) fwd_kernel(Params p) {
    extern __shared__ __attribute__((aligned(16))) unsigned char lds_raw[];
    LAS unsigned char* lds = (LAS unsigned char*)lds_raw;
    int tid = threadIdx.x, lane = tid & 63; const int wave = __builtin_amdgcn_readfirstlane(tid >> 6);
    volatile LAS unsigned* MISC = (volatile LAS unsigned*)(lds + LDS_BYTES - 256);
    if (tid < 64) MISC[tid] = 0u;
    __syncthreads();
    const XcdBarrier xbar = xcd_barrier_post((unsigned*)(p.ws + WS_CTL) + 4096, MISC + 8);
#define GSYNC() do { xcd_barrier(xbar); asm volatile("" : "+v"(lane), "+v"(tid)); } while (0)
    const int G = gridDim.x, gw = blockIdx.x * NWAVES + wave, NGW = G * NWAVES;
    unsigned char* ws = p.ws;
    float* RELB = (float*)(ws + WS_RELB); float* BINP = (float*)(ws + WS_BINP);
    h16* BT_IN = (h16*)(ws + WS_BT_IN); h16* BT_O = (h16*)(ws + WS_BT_O); h16* BT_Q = (h16*)(ws + WS_BT_Q); h16* BT_KV = (h16*)(ws + WS_BT_KV);
    h16* BT_WO = (h16*)(ws + WS_BT_WO); h16* BT_UP = (h16*)(ws + WS_BT_UP); h16* BT_DN = (h16*)(ws + WS_BT_DN);
    h16* MEM16 = (h16*)(ws + WS_MEM16); h16* KM = (h16*)(ws + WS_KVM); h16* VT = (h16*)(ws + WS_KVM + 4 * MiB); h16* X16 = (h16*)(ws + WS_X16); h16* MIX = (h16*)(ws + WS_MIX); h16* H = (h16*)(ws + WS_H);
    float* RAW = (float*)(ws + WS_RAW); h16* CB = (h16*)(ws + WS_CB); h16* IK16 = (h16*)(ws + WS_IK); float* IW = (float*)(ws + WS_IW); float* SCR = (float*)(ws + WS_SCR);
    h16* Q2 = (h16*)(ws + WS_Q2); h16* O2 = (h16*)(ws + WS_O2); h16* HFF = (h16*)(ws + WS_HFF);
    float* PRE = p.out;

    if (PHM & 1) {
        LAS float* scr = (LAS float*)(lds + wave * 16384);
        const float* W_IN = p.in[I_W_IN];
        constexpr int J0 = 16 * 16, J1 = 16 * 8, J2 = 16 * 4, J3 = 16 * 2, J4 = 16 * 16, J5 = 8 * 32, J6 = 16 * 32, J7 = 16 * 64, J8 = 16 * 32, J9 = 16 * 128, J10 = 64 * 32;
        constexpr int NIT = J0 + J1 + J2 + J3 + J4 + J5 + J6 + J7 + J8 + J9 + J10;
        for (int it = gw; it < NIT; it += NGW) {
            int r = it;
            if (r < J0) { p0_transpose_item(W_IN, DIN, 0, BT_IN, D, 0, 16, scr, r, lane); continue; } r -= J0;
            if (r < J1) { p0_transpose_item(W_IN, DIN, 512, BT_IN, D, 512, 8, scr, r, lane); continue; } r -= J1;
            if (r < J2) { p0_transpose_item(W_IN, DIN, 1280, BT_IN, D, 1792, 4, scr, r, lane); continue; } r -= J2;
            if (r < J3) { p0_transpose_item(W_IN, DIN, 1920, BT_IN, D, 1920, 2, scr, r, lane); continue; } r -= J3;
            if (r < J4) { p0_transpose_item(W_IN, DIN, 1408, BT_IN, D, 2048, 16, scr, r, lane); continue; } r -= J4;
            if (r < J5) { p0_transpose_item(p.in[I_W_O], D, 0, BT_O, MIXK, 0, 32, scr, r, lane); continue; } r -= J5;
            if (r < J6) { p0_transpose_item(p.in[I_WQ], D, 0, BT_Q, D, 0, 32, scr, r, lane); continue; } r -= J6;
            if (r < J7) { p0_transpose_item(p.in[I_WKV], 2 * D, 0, BT_KV, D, 0, 64, scr, r, lane); continue; } r -= J7;
            if (r < J8) { p0_transpose_item(p.in[I_WO], D, 0, BT_WO, D, 0, 32, scr, r, lane); continue; } r -= J8;
            if (r < J9) { p0_transpose_item(p.in[I_W_UP], FF, 0, BT_UP, D, 0, 128, scr, r, lane); continue; } r -= J9;
            p0_transpose_item(p.in[I_W_DN], D, 0, BT_DN, FF, 0, 32, scr, r, lane);
        }
        const float* WUK = p.in[I_W_UK]; const float* WUV = p.in[I_W_UV]; const float* W_O = p.in[I_W_O];
        for (int it = gw; it < 1024 * 16; it += NGW) {
            const int n = it >> 4, k = ((it & 15) << 6) + lane, h = n >> 7;
            const float* wr = W_IN + (size_t)k * DIN + 768 + 64 * h; const float* ur = WUK + (size_t)n * 64;
            float a = 0.f;
#pragma unroll 8
            for (int d = 0; d < 64; ++d) a += wr[d] * ur[d];
            ((f16*)BT_IN)[(size_t)(768 + n) * D + k] = (f16)(a * 0.125f);
        }
        for (int it = gw; it < 1024 * 16; it += NGW) {
            const int n = it >> 4, j = ((it & 15) << 6) + lane, h = j >> 7;
            const float* vr = WUV + (size_t)j * 64; const float* orow = W_O + (size_t)(512 + 64 * h) * D + n;
            float a = 0.f;
#pragma unroll 8
            for (int d = 0; d < 64; ++d) a += vr[d] * orow[(size_t)d * D];
            ((f16*)BT_O)[(size_t)n * MIXK + 512 + j] = (f16)a;
        }
        for (int it = gw; it < 64 * 16; it += NGW) {
            const int r = it >> 4, k = ((it & 15) << 6) + lane;
            const float v = (r < 8) ? W_IN[(size_t)k * DIN + 1984 + r] : 0.f;
            ((f16*)BT_IN)[(size_t)(1984 + r) * D + k] = (f16)v;
        }
        const float* B_IN = p.in[I_B_IN];
        for (int n = gw * 64 + lane; n < NIN; n += NGW * 64) {
            float v;
            if (n < 768) v = B_IN[n];
            else if (n < 1792) { const int j = n - 768, h = j >> 7; float a = 0.f; for (int d = 0; d < 64; ++d) a += B_IN[768 + 64 * h + d] * WUK[(size_t)j * 64 + d]; v = a * 0.125f; }
            else if (n < 1920) v = B_IN[1280 + (n - 1792)];
            else if (n < 1992) v = B_IN[n];
            else if (n < 2048) v = 0.f;
            else v = B_IN[1408 + (n - 2048)];
            BINP[n] = v;
        }
        const float* REL = p.in[I_REL];
        for (int i = gw * 64 + lane; i < 16 * 132; i += NGW * 64) { const int h = i / 132, d = i % 132; RELB[i] = REL[(int)REL_BUCKET[d > 128 ? 128 : d] * 16 + h]; }
        const float* MEMF = p.in[I_MEM];
        for (int i = gw * 64 + lane; i < MROWS * D / 4; i += NGW * 64) { const f32x4 v = ((const f32x4*)MEMF)[i]; u32x2 w; w.x = pk2h(v.x, v.y); w.y = pk2h(v.z, v.w); ((u32x2*)MEM16)[i] = w; }
        for (int m = gw; m < M; m += NGW) ln_row<true>(p.in[I_X] + (size_t)m * D, p.in[I_LNE_G], p.in[I_LNE_B], X16 + (size_t)m * D, lane);
    }
    GSYNC();

    if (PHM & 2) {
        pg8::Gemm g{X16, BT_IN, M, NIN, D}; pg8::StaticOrder S; S.init(M, NIN, G, (int)blockIdx.x);
        pg8::EpiIn E{H, NIN, BINP, RAW, RAWT};
        pg8::gemm_phase<pg8::EpiIn, pg8::StaticOrder, true, true>(lds, g, S, E);
    }
    if (PHM & 4) {
        pg8::Gemm g{MEM16, BT_KV, MROWS, 2 * D, D}; pg8::StaticOrder S; S.init(MROWS, 2 * D, G, (int)blockIdx.x);
        pg8::EpiKV E{KM, VT, p.in[I_BKV]};
        pg8::gemm_phase<pg8::EpiKV, pg8::StaticOrder, true, true>(lds, g, S, E);
    }
    GSYNC();

    if (PHM & 8) {
        const float* KG = p.in[I_KVN_G]; const float* IG = p.in[I_IKLN_G]; const float* IB = p.in[I_IKLN_B];
        for (int m = gw; m < M; m += NGW) {
            const float* r = RAW + (size_t)m * 256;
            const float c0 = r[lane], c1 = r[64 + lane];
            const float rr = 1.f / sqrtf(wave_sum(c0 * c0 + c1 * c1) * (1.f / 128.f) + LN_EPS);
            ((f16*)CB)[(size_t)m * 128 + lane] = (f16)(c0 * rr * KG[lane]); ((f16*)CB)[(size_t)m * 128 + 64 + lane] = (f16)(c1 * rr * KG[64 + lane]);
            const float k = r[128 + lane]; const float mu = wave_sum(k) * (1.f / 64.f); const float dk = k - mu;
            const float rs = 1.f / sqrtf(wave_sum(dk * dk) * (1.f / 64.f) + LN_EPS);
            ((f16*)IK16)[(size_t)m * 64 + lane] = (f16)(dk * rs * IG[lane] + IB[lane]);
            if (lane < 8) IW[(size_t)m * 8 + lane] = r[192 + lane] * (0.35355339059327373f * 0.125f);
        }
    }
    GSYNC();

    if (PHM & 32) {
        LAS unsigned short* idx_all = (LAS unsigned short*)(lds + 65536);
        LAS float* relb_s = (LAS float*)(lds + 65536 + 16384);
        LAS int* s_item = (LAS int*)(lds + 65536 + 16384 + 4224);
        LAS float* rba_s = (LAS float*)(lds + 86400);
        for (int i = tid; i < 8 * 132; i += NTHREADS) relb_s[i] = RELB[8 * 132 + i];
        for (int i = tid; i < 8 * 128; i += NTHREADS) rba_s[i] = RELB[(i >> 7) * 132 + (i & 127)];
        float* SCRW = SCR + (size_t)blockIdx.x * (32 * 4096);
        unsigned* qctr = (unsigned*)(ws + WS_CTL) + 64;
        for (;;) {
            __syncthreads();
            if (tid == 0) *s_item = (int)atomicAdd(qctr, 1u);
            __syncthreads();
            const int item = *s_item;
            if (item >= NB * 128 + 512) break;
            if (item >= NB * 128) {
                const int unit = item - NB * 128, kvh = unit & 1, n = (unit >> 1) & 31, b = unit >> 6;
                LAS unsigned char* Ks = lds;
                LAS unsigned char* Vt = lds + 32768;
                asm volatile("" : "+v"(lane), "+v"(tid));
#pragma unroll
                for (int i = 0; i < 4; ++i) {
                    const int pz = tid + 512 * i, r = pz >> 3, ch = pz & 7;
                    u32x4 kv = (u32x4){0u, 0u, 0u, 0u}, vv = (u32x4){0u, 0u, 0u, 0u};
                    if (n > 0 || r >= 128) { const f16* src = (const f16*)H + (size_t)(b * T + 128 * (n - 1) + r) * NIN + 512 + kvh * 64 + 8 * ch; kv = *(const u32x4*)src; vv = *(const u32x4*)(src + 128); }
                    *(LAS u32x4*)(Ks + r * 128 + ((ch ^ ((r >> 1) & 7)) << 4)) = kv;
                    LAS unsigned short* vd = (LAS unsigned short*)(Vt + (8 * ch) * 520 + r * 2);
                    vd[0 * 260] = (unsigned short)(vv.x & 0xffffu); vd[1 * 260] = (unsigned short)(vv.x >> 16); vd[2 * 260] = (unsigned short)(vv.y & 0xffffu); vd[3 * 260] = (unsigned short)(vv.y >> 16);
                    vd[4 * 260] = (unsigned short)(vv.z & 0xffffu); vd[5 * 260] = (unsigned short)(vv.z >> 16); vd[6 * 260] = (unsigned short)(vv.w & 0xffffu); vd[7 * 260] = (unsigned short)(vv.w >> 16);
                }
                __syncthreads();
                const int c = lane & 31, hi = lane >> 5, hd = 4 * kvh + (wave & 3), qhalf = wave >> 2;
                const float sink = p.in[I_SINKS][hd];
                const LAS float* rbh = rba_s + hd * 128;
#pragma unroll 1
                for (int sb = 0; sb < 2; ++sb) {
                    const int j0 = 2 * qhalf + sb, q0 = 32 * j0;
                    const size_t mrow = (size_t)(b * T + 128 * n + q0 + c);
                    f16x8 qf[4];
#pragma unroll
                    for (int ks = 0; ks < 4; ++ks) qf[ks] = *(const f16x8*)((const f16*)H + mrow * NIN + hd * 64 + 16 * ks + 8 * hi);
                    f32x16 S[5];
#pragma unroll
                    for (int jt = 0; jt < 5; ++jt) {
#pragma unroll
                        for (int r = 0; r < 16; ++r) S[jt][r] = 0.f;
#pragma unroll
                        for (int ks = 0; ks < 4; ++ks) {
                            const f16x8 a = *(const LAS f16x8*)(Ks + (32 * (j0 + jt) + c) * 128 + (((2 * ks + hi) ^ ((c >> 1) & 7)) << 4));
                            S[jt] = __builtin_amdgcn_mfma_f32_32x32x16_f16(a, qf[ks], S[jt], 0, 0, 0);
                        }
                    }
                    float mx = sink;
#pragma unroll
                    for (int jt = 0; jt < 5; ++jt)
#pragma unroll
                        for (int r = 0; r < 16; ++r) {
                            const int si = 32 * (j0 + jt) + (r & 3) + 8 * (r >> 2) + 4 * hi; const int rel = q0 + c + 128 - si;
                            const bool valid = (rel >= 0) && (rel < 128) && (n > 0 || si >= 128);
                            const float l = valid ? S[jt][r] * 0.125f + rbh[rel & 127] : NEG_INF;
                            S[jt][r] = l; mx = fmaxf(mx, l);
                        }
                    mx = fmaxf(mx, __shfl_xor(mx, 32));
                    float sum = 0.f;
#pragma unroll
                    for (int jt = 0; jt < 5; ++jt)
#pragma unroll
                        for (int r = 0; r < 16; ++r) { const float e = __expf(S[jt][r] - mx); S[jt][r] = e; sum += e; }
                    sum += __shfl_xor(sum, 32);
                    const float inv = 1.f / (sum + __expf(sink - mx));
                    f32x16 o[2];
#pragma unroll
                    for (int dt = 0; dt < 2; ++dt)
#pragma unroll
                        for (int r = 0; r < 16; ++r) o[dt][r] = 0.f;
#pragma unroll
                    for (int jt = 0; jt < 5; ++jt)
#pragma unroll
                        for (int s = 0; s < 2; ++s) {
                            f16x8 pb;
#pragma unroll
                            for (int j = 0; j < 8; ++j) pb[j] = (f16)S[jt][8 * s + j];
#pragma unroll
                            for (int dt = 0; dt < 2; ++dt) {
                                const LAS unsigned char* vp = Vt + (32 * dt + c) * 520 + (32 * (j0 + jt) + 16 * s + 4 * hi) * 2;
                                const f16x4 v0 = *(const LAS f16x4*)vp, v1 = *(const LAS f16x4*)(vp + 16);
                                const f16x8 av = (f16x8){v0[0], v0[1], v0[2], v0[3], v1[0], v1[1], v1[2], v1[3]};
                                o[dt] = __builtin_amdgcn_mfma_f32_32x32x16_f16(av, pb, o[dt], 0, 0, 0);
                            }
                        }
                    f16* op = (f16*)MIX + mrow * MIXK + hd * 64 + 4 * hi;
#pragma unroll
                    for (int dt = 0; dt < 2; ++dt)
#pragma unroll
                        for (int rq = 0; rq < 4; ++rq) { u32x2 w; w.x = pk2h(o[dt][4 * rq] * inv, o[dt][4 * rq + 1] * inv); w.y = pk2h(o[dt][4 * rq + 2] * inv, o[dt][4 * rq + 3] * inv); *(u32x2*)(op + 32 * dt + 8 * rq) = w; }
                }
                continue;
            }
            const int qb32 = 127 - (item >> 3), b = item & 7;
            const int m0 = b * T + 32 * qb32;
            asm volatile("" : "+v"(lane));
            const int c32 = lane & 31, hi = lane >> 5;
            {
                f16x8 bq[8][4];
                const f16* iqp = (const f16*)H + (size_t)(m0 + c32) * NIN + 2048 + 8 * hi;
#pragma unroll
                for (int h = 0; h < 8; ++h)
#pragma unroll
                    for (int ks = 0; ks < 4; ++ks) bq[h][ks] = *(const f16x8*)(iqp + h * 64 + ks * 16);
                float iwv[8];
                { const f32x4 w0 = *(const f32x4*)(IW + (size_t)(m0 + c32) * 8), w1 = *(const f32x4*)(IW + (size_t)(m0 + c32) * 8 + 4);
                  iwv[0] = w0.x; iwv[1] = w0.y; iwv[2] = w0.z; iwv[3] = w0.w; iwv[4] = w1.x; iwv[5] = w1.y; iwv[6] = w1.z; iwv[7] = w1.w; }
                for (int kt = wave; kt <= qb32; kt += 8) {
                    const f16* ikp = (const f16*)IK16 + (size_t)(b * T + kt * 32 + c32) * 64 + 8 * hi;
                    f16x8 ak[4];
#pragma unroll
                    for (int ks = 0; ks < 4; ++ks) ak[ks] = *(const f16x8*)(ikp + ks * 16);
                    float sc[16];
#pragma unroll
                    for (int r = 0; r < 16; ++r) sc[r] = 0.f;
#pragma unroll
                    for (int h = 0; h < 8; ++h) {
                        f32x16 acc;
#pragma unroll
                        for (int r = 0; r < 16; ++r) acc[r] = 0.f;
#pragma unroll
                        for (int ks = 0; ks < 4; ++ks) acc = __builtin_amdgcn_mfma_f32_32x32x16_f16(ak[ks], bq[h][ks], acc, 0, 0, 0);
#pragma unroll
                        for (int r = 0; r < 16; ++r) { const int ai = __float_as_int(acc[r]); sc[r] += iwv[h] * __int_as_float(ai < 0 ? 0 : ai); }
#pragma unroll
                        for (int r = 0; r < 16; ++r) asm volatile("" : "+v"(sc[r]));
                    }
                    float* sp = SCRW + (size_t)c32 * 4096 + kt * 32 + 4 * hi;
#pragma unroll
                    for (int i = 0; i < 4; ++i) *(f32x4*)(sp + 8 * i) = (f32x4){sc[4 * i], sc[4 * i + 1], sc[4 * i + 2], sc[4 * i + 3]};
                }
            }
            asm volatile("s_waitcnt vmcnt(0)" ::: "memory");
            __syncthreads();
#pragma unroll 1
            for (int qi = 0; qi < 4; ++qi) {
                const int q = 4 * wave + qi, t = 32 * qb32 + q, m = m0 + q;
                int lane_o = lane; asm volatile("" : "+v"(lane_o));
                const int head = lane_o & 15, g = lane_o >> 4;
                LAS unsigned char* gb = lds + wave * 8192;
                LAS unsigned short* idxq = idx_all + q * 256;
                int cnt;
                {
                    unsigned u[64];
                    const float* sb = SCRW + (size_t)q * 4096 + lane; asm volatile("" : "+v"(sb));
                    const int ngrp = (t >> 10) + 1;
#pragma unroll
                    for (int gq = 0; gq < 4; ++gq) {
                        if (gq < ngrp) {
#pragma unroll
                            for (int jj = 0; jj < 16; ++jj) { const int j = gq * 16 + jj; const float v = ld_sc1(sb + 64 * j); u[j] = (64 * j + lane <= t) ? mono_key(v) : 0u; }
                        } else {
#pragma unroll
                            for (int jj = 0; jj < 16; ++jj) u[gq * 16 + jj] = 0u;
                        }
                    }
                    cnt = select_topk(u, t + 1, ngrp, idxq, lane);
                    for (int e = cnt + lane; e < 256; e += 64) idxq[e] = 0;
                }
                asm volatile("s_waitcnt lgkmcnt(0)" ::: "memory");
                {
                    f16x8 qf[4];
                    { const f16* qp = (const f16*)H + (size_t)m * NIN + 768 + (head & 7) * 128 + 8 * g;
#pragma unroll
                      for (int ks = 0; ks < 4; ++ks) { f16x8 v = *(const f16x8*)(qp + 32 * ks); if (head >= 8) v = (f16x8){0, 0, 0, 0, 0, 0, 0, 0}; qf[ks] = v; } }
                    const f16* cbb = (const f16*)CB + (size_t)(b * T) * 128 + (lane_o & 15) * 8;
                    u32x4 gr[8];
#pragma unroll
                    for (int i = 0; i < 8; ++i) { const int s = (int)idxq[4 * i + g]; gr[i] = *(const u32x4*)(cbb + (size_t)s * 128); }
                    float m_run = -3.0e38f, l_part = 0.f;
                    f32x4 o[8];
#pragma unroll
                    for (int ct = 0; ct < 8; ++ct) o[ct] = (f32x4){0.f, 0.f, 0.f, 0.f};
                    const int rowA0 = 8 * ((lane_o & 15) >> 2) + (lane_o & 3);
                    const LAS float* rbh = relb_s + (head & 7) * 132;
#pragma unroll 1
                    for (int chunk = 0; chunk < 8; ++chunk) {
#pragma unroll
                        for (int i = 0; i < 8; ++i) *(LAS u32x4*)(gb + off_b(4 * i + g, lane & 15)) = gr[i];
                        if (chunk < 7) {
#pragma unroll
                            for (int i = 0; i < 8; ++i) { const int s = (int)idxq[(chunk + 1) * 32 + 4 * i + g]; gr[i] = *(const u32x4*)(cbb + (size_t)s * 128); }
                        }
                        f32x4 S0 = (f32x4){0.f, 0.f, 0.f, 0.f}, S1 = (f32x4){0.f, 0.f, 0.f, 0.f};
#pragma unroll
                        for (int ks = 0; ks < 4; ++ks) {
                            const f16x8 a0 = *(const LAS f16x8*)(gb + off_b(rowA0, 4 * ks + g)), a1 = *(const LAS f16x8*)(gb + off_b(rowA0 + 4, 4 * ks + g));
                            S0 = __builtin_amdgcn_mfma_f32_16x16x32_f16(a0, qf[ks], S0, 0, 0, 0);
                            S1 = __builtin_amdgcn_mfma_f32_16x16x32_f16(a1, qf[ks], S1, 0, 0, 0);
                        }
                        const u16x8 myi = *(const LAS u16x8*)(idxq + chunk * 32 + 8 * g);
                        float lg[8];
#pragma unroll
                        for (int j = 0; j < 8; ++j) { const int s = (int)myi[j]; int dist = t - s; dist = dist > 128 ? 128 : dist; const float sv = (j < 4) ? S0[j & 3] : S1[j & 3];
                            lg[j] = (chunk * 32 + 8 * g + j < cnt) ? sv + rbh[dist] : NEG_INF; }
                        float mx = fmaxf(fmaxf(fmaxf(lg[0], lg[1]), fmaxf(lg[2], lg[3])), fmaxf(fmaxf(lg[4], lg[5]), fmaxf(lg[6], lg[7])));
                        mx = fmaxf(mx, __shfl_xor(mx, 16)); mx = fmaxf(mx, __shfl_xor(mx, 32));
                        const float m_new = fmaxf(m_run, mx); const float scl = __expf(m_run - m_new); m_run = m_new;
                        float pr[8]; float ps = 0.f;
#pragma unroll
                        for (int j = 0; j < 8; ++j) { pr[j] = __expf(lg[j] - m_new); ps += pr[j]; }
                        l_part = l_part * scl + ps;
                        f16x8 pb;
#pragma unroll
                        for (int j = 0; j < 8; ++j) pb[j] = (f16)pr[j];
#pragma unroll
                        for (int ct = 0; ct < 8; ++ct) {
                            const v4i16 t0 = __builtin_amdgcn_ds_read_tr16_b64_v4i16((LAS v4i16*)(gb + tr_addr16(lane_o, ct, 0)));
                            const v4i16 t1 = __builtin_amdgcn_ds_read_tr16_b64_v4i16((LAS v4i16*)(gb + tr_addr16(lane_o, ct, 1)));
                            const v8i16 av = (v8i16){t0[0], t0[1], t0[2], t0[3], t1[0], t1[1], t1[2], t1[3]};
                            o[ct] = o[ct] * scl;
                            o[ct] = __builtin_amdgcn_mfma_f32_16x16x32_f16(__builtin_bit_cast(f16x8, av), pb, o[ct], 0, 0, 0);
                        }
                    }
                    float l_tot = l_part; l_tot += __shfl_xor(l_tot, 16); l_tot += __shfl_xor(l_tot, 32);
                    const float inv = 1.f / l_tot;
                    if (head < 8) {
                        f16* op = (f16*)MIX + (size_t)m * MIXK + 512 + head * 128 + 4 * g;
#pragma unroll
                        for (int ct = 0; ct < 8; ++ct) { u32x2 w; w.x = pk2h(o[ct][0] * inv, o[ct][1] * inv); w.y = pk2h(o[ct][2] * inv, o[ct][3] * inv); *(u32x2*)(op + 16 * ct) = w; }
                    }
                }
            }
        }
    }
    GSYNC();

    if (PHM & 64) {
        pg8::Gemm g{MIX, BT_O, M, D, MIXK}; pg8::StaticOrder S; S.init(M, D, G, (int)blockIdx.x);
        pg8::EpiPre E{X16, PRE, D, p.in[I_B_O], DN_ALPHA};
        pg8::gemm_phase<pg8::EpiPre, pg8::StaticOrder, true, true>(lds, g, S, E);
    }
    GSYNC();
    for (int m = gw; m < M; m += NGW) ln_row<true>(PRE + (size_t)m * D, p.in[I_LN1_G], p.in[I_LN1_B], X16 + (size_t)m * D, lane);
    GSYNC();

    if (PHM & 128) {
        pg8::Gemm g{X16, BT_Q, M, D, D}; pg8::StaticOrder S; S.init(M, D, G, (int)blockIdx.x);
        pg8::EpiF16<0> E{Q2, D, p.in[I_BQ]};
        pg8::gemm_phase<pg8::EpiF16<0>, pg8::StaticOrder, true, true>(lds, g, S, E);
    }
    GSYNC();

    if (PHM & 256) {
        LAS unsigned char* Ks = lds;
        LAS unsigned char* Vs = lds + 32768;
        const int q16 = lane & 15, g = lane >> 4;
        for (int unit = blockIdx.x; unit < 1024; unit += G) {
            const int qblk = unit & 31, head = (unit >> 5) & 3, b = unit >> 7;
            const size_t mrow = (size_t)b * T + qblk * 128 + wave * 16 + q16;
            f16x8 qf[8];
#pragma unroll
            for (int ks = 0; ks < 8; ++ks) qf[ks] = *(const f16x8*)((const f16*)Q2 + mrow * D + head * 256 + 32 * ks + 8 * g);
            f32x4 o[16];
#pragma unroll
            for (int dt = 0; dt < 16; ++dt) o[dt] = (f32x4){0.f, 0.f, 0.f, 0.f};
            float m_run = -3.0e38f, l_part = 0.f;
#pragma unroll 1
            for (int c = 0; c < 4; ++c) {
                __syncthreads();
#pragma unroll
                for (int i = 0; i < 4; ++i) {
                    const int pz = tid + 512 * i;
                    { const int r = pz >> 5, ch = pz & 31;
                      const u32x4 v = *(const u32x4*)((const f16*)KM + (size_t)(b * MEML + 64 * c + r) * D + head * 256 + 8 * ch);
                      *(LAS u32x4*)(Ks + r * 512 + ((ch ^ (r & 15)) << 4)) = v; }
                    { const int d = pz >> 3, pc = pz & 7;
                      const u32x4 v = *(const u32x4*)((const f16*)VT + (size_t)((b * 4 + head) * 256 + d) * MEML + 64 * c + 8 * pc);
                      *(LAS u32x4*)(Vs + d * 144 + pc * 16) = v; }
                }
                __syncthreads();
                f32x4 S[4];
#pragma unroll
                for (int u = 0; u < 4; ++u) {
                    S[u] = (f32x4){0.f, 0.f, 0.f, 0.f};
#pragma unroll
                    for (int ks = 0; ks < 8; ++ks) {
                        const f16x8 a = *(const LAS f16x8*)(Ks + (16 * u + q16) * 512 + (((4 * ks + g) ^ q16) << 4));
                        S[u] = __builtin_amdgcn_mfma_f32_16x16x32_f16(a, qf[ks], S[u], 0, 0, 0);
                    }
                }
                float mx = -3.0e38f;
#pragma unroll
                for (int u = 0; u < 4; ++u)
#pragma unroll
                    for (int r = 0; r < 4; ++r) { S[u][r] *= 0.0625f; mx = fmaxf(mx, S[u][r]); }
                mx = fmaxf(mx, __shfl_xor(mx, 16)); mx = fmaxf(mx, __shfl_xor(mx, 32));
                const float m_new = fmaxf(m_run, mx); const float scl = __expf(m_run - m_new); m_run = m_new;
                float ps = 0.f;
#pragma unroll
                for (int u = 0; u < 4; ++u)
#pragma unroll
                    for (int r = 0; r < 4; ++r) { S[u][r] = __expf(S[u][r] - m_new); ps += S[u][r]; }
                l_part = l_part * scl + ps;
                f16x8 pb[2];
#pragma unroll
                for (int v = 0; v < 2; ++v)
#pragma unroll
                    for (int j = 0; j < 4; ++j) { pb[v][j] = (f16)S[2 * v][j]; pb[v][4 + j] = (f16)S[2 * v + 1][j]; }
#pragma unroll
                for (int dt = 0; dt < 16; ++dt) {
                    o[dt] = o[dt] * scl;
#pragma unroll
                    for (int v = 0; v < 2; ++v) {
                        const LAS unsigned char* vp = Vs + (16 * dt + q16) * 144 + (32 * v + 4 * g) * 2;
                        const f16x4 v0 = *(const LAS f16x4*)vp, v1 = *(const LAS f16x4*)(vp + 32);
                        const f16x8 av = (f16x8){v0[0], v0[1], v0[2], v0[3], v1[0], v1[1], v1[2], v1[3]};
                        o[dt] = __builtin_amdgcn_mfma_f32_16x16x32_f16(av, pb[v], o[dt], 0, 0, 0);
                    }
                }
            }
            float l_tot = l_part; l_tot += __shfl_xor(l_tot, 16); l_tot += __shfl_xor(l_tot, 32);
            const float inv = 1.f / l_tot;
            f16* op = (f16*)O2 + mrow * D + head * 256 + 4 * g;
#pragma unroll
            for (int dt = 0; dt < 16; ++dt) { u32x2 w; w.x = pk2h(o[dt][0] * inv, o[dt][1] * inv); w.y = pk2h(o[dt][2] * inv, o[dt][3] * inv); *(u32x2*)(op + 16 * dt) = w; }
        }
    }
    GSYNC();

    if (PHM & 512) {
        pg8::Gemm g{O2, BT_WO, M, D, D}; pg8::StaticOrder S; S.init(M, D, G, (int)blockIdx.x);
        pg8::EpiPre E{X16, PRE, D, p.in[I_BO], DN_ALPHA};
        pg8::gemm_phase<pg8::EpiPre, pg8::StaticOrder, true, true>(lds, g, S, E);
    }
    GSYNC();
    for (int m = gw; m < M; m += NGW) ln_row<true>(PRE + (size_t)m * D, p.in[I_LN2_G], p.in[I_LN2_B], X16 + (size_t)m * D, lane);
    GSYNC();

    if (PHM & 1024) {
        pg8::Gemm g{X16, BT_UP, M, FF, D}; pg8::StaticOrder S; S.init(M, FF, G, (int)blockIdx.x);
        pg8::EpiF16<2> E{HFF, FF, p.in[I_B_UP]};
        pg8::gemm_phase<pg8::EpiF16<2>, pg8::StaticOrder, true, true>(lds, g, S, E);
    }
    GSYNC();
    if (PHM & 2048) {
        pg8::Gemm g{HFF, BT_DN, M, D, FF}; pg8::StaticOrder S; S.init(M, D, G, (int)blockIdx.x);
        pg8::EpiPre E{X16, PRE, D, p.in[I_B_DN], DN_ALPHA};
        pg8::gemm_phase<pg8::EpiPre, pg8::StaticOrder, true, true>(lds, g, S, E);
    }
    GSYNC();
    for (int m = gw; m < M; m += NGW) ln_row<false>(PRE + (size_t)m * D, p.in[I_LN3_G], p.in[I_LN3_B], p.out + (size_t)m * D, lane);
}

extern "C" void kernel_launch(void* const* d_in, const int* in_sizes, int n_in, void* d_out, int out_size, void* d_ws, size_t ws_size, hipStream_t stream) {
    static int grid = 0;
    if (grid == 0) {
        if (n_in != 31 || out_size != M * D || ws_size < WS_END) { fprintf(stderr, "kernel_launch: unexpected shapes (n_in %d, out %d, ws %zu)\n", n_in, out_size, ws_size); grid = -1; return; }
        int dev = 0, cus = 0, per_cu = 0;
        hipGetDevice(&dev); hipDeviceGetAttribute(&cus, hipDeviceAttributeMultiprocessorCount, dev);
        hipFuncSetAttribute((const void*)fwd_kernel, hipFuncAttributeMaxDynamicSharedMemorySize, LDS_BYTES);
        hipOccupancyMaxActiveBlocksPerMultiprocessor(&per_cu, (const void*)fwd_kernel, NTHREADS, LDS_BYTES);
        if (per_cu < 1) { fprintf(stderr, "kernel_launch: occupancy query says %d blocks per CU\n", per_cu); grid = -1; return; }
        grid = cus;
    }
    if (grid < 0) return;
    hipMemsetAsync((char*)d_ws + WS_CTL, 0, CTL_BYTES, stream);
    Params p{};
    for (int i = 0; i < 31; ++i) p.in[i] = (const float*)d_in[i];
    p.out = (float*)d_out; p.ws = (unsigned char*)d_ws;
    void* args[] = {&p};
    hipError_t e = hipLaunchCooperativeKernel((const void*)fwd_kernel, dim3(grid), dim3(NTHREADS), args, LDS_BYTES, stream);
    if (e != hipSuccess) fprintf(stderr, "cooperative launch failed: %s (grid %d)\n", hipGetErrorString(e), grid);
}
```

```cpp
#include <hip/hip_runtime.h>
#include <hip/hip_cooperative_groups.h>
#include <cstdio>
#include <cstdint>
namespace cg = cooperative_groups;

namespace pg8 {
#define PG8_LAS __attribute__((address_space(3)))
typedef unsigned short bf16_t;
typedef _Float16 bf16x8 __attribute__((ext_vector_type(8)));
typedef float f32x4 __attribute__((ext_vector_type(4)));
typedef unsigned u32x4 __attribute__((ext_vector_type(4)));
typedef unsigned u32x2 __attribute__((ext_vector_type(2)));
typedef float f32x2 __attribute__((ext_vector_type(2)));
typedef _Float16 f16x2 __attribute__((ext_vector_type(2)));
typedef _Float16 f16x4 __attribute__((ext_vector_type(4)));
constexpr int BM = 256, BK = 64, HALF = 128, HTB = HALF * BK * 2, STAGE_BYTES = 8 * HTB, NXCD = 8, WGM = 8;

__host__ __device__ __forceinline__ int lds_byte(int r, int c) { const int st = (r >> 4) * 2 + (c >> 5), rr = r & 15, cc = c & 31, ob = rr * 64 + cc * 2; return st * 1024 + (ob ^ (((ob >> 9) & 1) << 5)); }
__host__ __device__ __forceinline__ void stage_rc(int b, int& R, int& C) { const int st = b / 1024, sb = b % 1024, swz = sb ^ (((sb >> 9) & 1) << 5); R = (st >> 1) * 16 + swz / 64; C = (st & 1) * 32 + (swz % 64) / 2; }
__host__ __device__ __forceinline__ int perm32(int rho) { const int n = rho >> 4, i = rho & 15; return 8 * (i >> 2) + 4 * n + (i & 3); }

struct Unit { int pm, pn; };
struct Gemm { const bf16_t* A; const bf16_t* Bt; int M, N, K; };

struct StaticOrder {
    int nM, nN, nwg, G, c;
    __host__ __device__ void init(int M, int N, int G_, int c_) { nM = M / BM; nN = N / BM; nwg = nM * nN; G = G_; c = c_; }
    __host__ __device__ bool next(int i, Unit& u) const {
        const long L = (long)i * G + c; if (L >= nwg) return false;
        int wgid = (int)L; { const int q = nwg / NXCD, r = nwg % NXCD, xcd = wgid % NXCD, off = wgid / NXCD; wgid = (xcd < r ? xcd * (q + 1) : r * (q + 1) + (xcd - r) * q) + off; }
        const int nig = WGM * nN, gid = wgid / nig, fm = gid * WGM, gsz = (nM - fm) < WGM ? (nM - fm) : WGM;
        u.pm = fm + ((wgid % nig) % gsz); u.pn = (wgid % nig) / gsz; return true;
    }
    __device__ __forceinline__ void a_ready(const Unit&) const {}
    __device__ __forceinline__ void done(const Unit&) const {}
};

__device__ __forceinline__ unsigned pk_f16(float lo, float hi) { f32x2 v = {lo, hi}; f16x2 h = __builtin_convertvector(v, f16x2); return __builtin_bit_cast(unsigned, h); }

template <int ACT  > struct EpiF16 {
    static constexpr bool PERM = true, AFTER_DRAIN = false;
    bf16_t* O; int ldc; const float* bias;
    __device__ __forceinline__ void operator()(const f32x4 (&acc)[2][2][4][2], const Unit& u, int wr, int wc, int fr, int fq) const {
        const int row0 = u.pm * BM + wr * 64 + fr; const int col0 = u.pn * BM + wc * 32 + 8 * fq;
        f32x4 bv[2][2];
#pragma unroll
        for (int bj = 0; bj < 2; ++bj)
#pragma unroll
            for (int n = 0; n < 2; ++n) bv[bj][n] = *(const f32x4*)(bias + col0 + bj * HALF + 4 * n);
#pragma unroll
        for (int ai = 0; ai < 2; ++ai)
#pragma unroll
            for (int m = 0; m < 4; ++m) { bf16_t* rowp = O + (size_t)(row0 + ai * HALF + m * 16) * ldc + col0;
#pragma unroll
                for (int bj = 0; bj < 2; ++bj) { f32x4 v0 = acc[ai][bj][m][0] + bv[bj][0], v1 = acc[ai][bj][m][1] + bv[bj][1];
                    if (ACT == 2) {
#pragma unroll
                        for (int e = 0; e < 4; ++e) { const float a = fmaxf(v0[e], 0.f), b = fmaxf(v1[e], 0.f); v0[e] = a * a; v1[e] = b * b; } }
                    u32x4 w; w.x = pk_f16(v0[0], v0[1]); w.y = pk_f16(v0[2], v0[3]); w.z = pk_f16(v1[0], v1[1]); w.w = pk_f16(v1[2], v1[3]);
                    *(u32x4*)(rowp + bj * HALF) = w; } }
    }
};
struct EpiIn {
    static constexpr bool PERM = true, AFTER_DRAIN = false;
    bf16_t* O; int ldc; const float* bias; float* RAW; int rawt;
    __device__ __forceinline__ void operator()(const f32x4 (&acc)[2][2][4][2], const Unit& u, int wr, int wc, int fr, int fq) const {
        const int row0 = u.pm * BM + wr * 64 + fr; const int col0 = u.pn * BM + wc * 32 + 8 * fq;
        f32x4 bv[2][2];
#pragma unroll
        for (int bj = 0; bj < 2; ++bj)
#pragma unroll
            for (int n = 0; n < 2; ++n) bv[bj][n] = *(const f32x4*)(bias + col0 + bj * HALF + 4 * n);
        const bool raw = (u.pn == rawt);
#pragma unroll
        for (int ai = 0; ai < 2; ++ai)
#pragma unroll
            for (int m = 0; m < 4; ++m) { const size_t row = (size_t)(row0 + ai * HALF + m * 16); bf16_t* rowp = O + row * ldc + col0; float* rawp = RAW + row * 256 + wc * 32 + 8 * fq;
#pragma unroll
                for (int bj = 0; bj < 2; ++bj) { const f32x4 v0 = acc[ai][bj][m][0] + bv[bj][0], v1 = acc[ai][bj][m][1] + bv[bj][1];
                    if (raw) { *(f32x4*)(rawp + bj * HALF) = v0; *(f32x4*)(rawp + bj * HALF + 4) = v1; }
                    else { u32x4 w; w.x = pk_f16(v0[0], v0[1]); w.y = pk_f16(v0[2], v0[3]); w.z = pk_f16(v1[0], v1[1]); w.w = pk_f16(v1[2], v1[3]);
                        *(u32x4*)(rowp + bj * HALF) = w; } } }
    }
};
struct EpiKV {
    static constexpr bool PERM = true, AFTER_DRAIN = false;
    bf16_t* KM; bf16_t* VT; const float* bias;
    __device__ __forceinline__ void operator()(const f32x4 (&acc)[2][2][4][2], const Unit& u, int wr, int wc, int fr, int fq) const {
        const int col0 = u.pn * BM + wc * 32 + 8 * fq;
        f32x4 bv[2][2];
#pragma unroll
        for (int bj = 0; bj < 2; ++bj)
#pragma unroll
            for (int n = 0; n < 2; ++n) bv[bj][n] = *(const f32x4*)(bias + col0 + bj * HALF + 4 * n);
        const bool isv = u.pn >= 4;
#pragma unroll
        for (int ai = 0; ai < 2; ++ai)
#pragma unroll
            for (int m = 0; m < 4; ++m) { const int j = wr * 64 + fr + ai * HALF + m * 16;
#pragma unroll
                for (int bj = 0; bj < 2; ++bj) { const f32x4 v0 = acc[ai][bj][m][0] + bv[bj][0], v1 = acc[ai][bj][m][1] + bv[bj][1];
                    if (!isv) { u32x4 w; w.x = pk_f16(v0[0], v0[1]); w.y = pk_f16(v0[2], v0[3]); w.z = pk_f16(v1[0], v1[1]); w.w = pk_f16(v1[2], v1[3]);
                        *(u32x4*)(KM + (size_t)(u.pm * BM + j) * 1024 + col0 + bj * HALF) = w; }
                    else { _Float16* vt = (_Float16*)VT + ((size_t)(u.pm * 4 + (u.pn - 4)) * 256 + (wc * 32 + 8 * fq + bj * HALF)) * 256 + j;
#pragma unroll
                        for (int e = 0; e < 4; ++e) { vt[(size_t)e * 256] = (_Float16)v0[e]; vt[(size_t)(4 + e) * 256] = (_Float16)v1[e]; } } } }
    }
};
struct EpiPre {
    static constexpr bool PERM = false, AFTER_DRAIN = false;
    const bf16_t* base; float* out; int ldc; const float* bias; float alpha;
    __device__ __forceinline__ void operator()(const f32x4 (&acc)[2][2][4][2], const Unit& u, int wr, int wc, int fr, int fq) const {
        const int col0 = u.pn * BM + wc * 32 + 4 * fq;
        f32x4 bv[2][2];
#pragma unroll
        for (int bj = 0; bj < 2; ++bj)
#pragma unroll
            for (int n = 0; n < 2; ++n) bv[bj][n] = *(const f32x4*)(bias + col0 + bj * HALF + n * 16);
#pragma unroll
        for (int ai = 0; ai < 2; ++ai)
#pragma unroll
            for (int m = 0; m < 4; ++m) { const size_t off = (size_t)(u.pm * BM + ai * HALF + wr * 64 + m * 16 + fr) * ldc + col0;
#pragma unroll
                for (int bj = 0; bj < 2; ++bj)
#pragma unroll
                    for (int n = 0; n < 2; ++n) { const f16x4 bs = *(const f16x4*)(base + off + bj * HALF + n * 16);
                        f32x4 v = acc[ai][bj][m][n] + bv[bj][n];
#pragma unroll
                        for (int e = 0; e < 4; ++e) v[e] += alpha * (float)bs[e];
                        *(f32x4*)(out + off + bj * HALF + n * 16) = v; } }
    }
};

template <class Epi, class Sched, bool ALIGN_EPI = false, bool SP2 = false>
__device__ __forceinline__ void gemm_phase(PG8_LAS unsigned char* lds, const Gemm g, const Sched& S, const Epi& E) {
    int tid_ = threadIdx.x; asm volatile("" : "+v"(tid_));
    const int tid = tid_, wid = __builtin_amdgcn_readfirstlane(tid >> 6), lane = tid & 63, wr = wid >> 2, wc = wid & 3, fr = lane & 15, fq = lane >> 4;
    const int K = g.K, nt = K / BK;
    unsigned voffA[2], voffB[2];
#pragma unroll
    for (int i = 0; i < 2; ++i) { int R, C; stage_rc(tid * 16 + i * 8192, R, C); const int Rb = Epi::PERM ? ((R & ~31) + perm32(R & 31)) : R;
        voffA[i] = (unsigned)(R * K + C) * 2u; voffB[i] = (unsigned)(Rb * K + C) * 2u; }
    const size_t kstep = (size_t)(BK * 2);
    const size_t hstep = (size_t)HALF * K * 2;
    const size_t tstep = 2 * hstep;
    const unsigned ldsw = (unsigned)wid * 1024u;
    const int aoff = lds_byte(wr * 64 + fr, fq * 8), boff = lds_byte(wc * 32 + fr, fq * 8);
#define PG8_SA(b, h) (((b) * 2 + (h)) * HTB)
#define PG8_SB(b, h) ((4 + (b) * 2 + (h)) * HTB)
#define PG8_STAGE(bufoff, gbase, voff) do { _Pragma("unroll") for (int _i = 0; _i < 2; ++_i) \
        __builtin_amdgcn_global_load_lds((const unsigned*)((const char*)(gbase) + (voff)[_i]), (PG8_LAS unsigned*)(lds + (bufoff) + ldsw + _i * 8192), 16, 0, 0); } while (0)
#define PG8_LDA(dst, b, h) do { _Pragma("unroll") for (int m = 0; m < 4; ++m) _Pragma("unroll") for (int k = 0; k < 2; ++k) dst[m][k] = *(const PG8_LAS bf16x8*)(lds + PG8_SA(b, h) + aoff + m * 2048 + k * 1024); } while (0)
#define PG8_LDB(dst, b, h) do { _Pragma("unroll") for (int n = 0; n < 2; ++n) _Pragma("unroll") for (int k = 0; k < 2; ++k) dst[n][k] = *(const PG8_LAS bf16x8*)(lds + PG8_SB(b, h) + boff + n * 2048 + k * 1024); } while (0)
#define PG8_MMA(ai, bj, At, Bt) do { __builtin_amdgcn_s_setprio(1); _Pragma("unroll") for (int m = 0; m < 4; ++m) _Pragma("unroll") for (int n = 0; n < 2; ++n) _Pragma("unroll") for (int k = 0; k < 2; ++k) \
        acc[ai][bj][m][n] = __builtin_amdgcn_mfma_f32_16x16x32_f16(Bt[n][k], At[m][k], acc[ai][bj][m][n], 0, 0, 0); __builtin_amdgcn_s_setprio(0); } while (0)
#define PG8_WAIT_V(n) asm volatile("s_waitcnt vmcnt(" #n ")" ::: "memory")
#define PG8_WAIT_L(n) asm volatile("s_waitcnt lgkmcnt(" #n ")" ::: "memory")
#define PG8_BAR __builtin_amdgcn_s_barrier()
#define PG8_SCHED __builtin_amdgcn_sched_barrier(0)
    Unit cur, nxt; int ui = 0;
    if (!S.next(0, cur)) return;
    f32x4 acc[2][2][4][2];
#pragma unroll
    for (int a = 0; a < 2; ++a)
#pragma unroll
        for (int b = 0; b < 2; ++b)
#pragma unroll
            for (int m = 0; m < 4; ++m)
#pragma unroll
                for (int n = 0; n < 2; ++n) acc[a][b][m][n] = (f32x4){0.f, 0.f, 0.f, 0.f};
    bf16x8 At[4][2], B0[2][2], B1[2][2];
    const char* cA = (const char*)g.A + (size_t)cur.pm * tstep; const char* cB = (const char*)g.Bt + (size_t)cur.pn * tstep;
    S.a_ready(cur);
    if constexpr (SP2) {
        PG8_STAGE(PG8_SB(0, 0), cB, voffB); PG8_STAGE(PG8_SB(0, 1), cB + hstep, voffB); PG8_STAGE(PG8_SA(0, 0), cA, voffA); PG8_STAGE(PG8_SA(0, 1), cA + hstep, voffA);
        if (wr == 1) PG8_BAR;
        PG8_WAIT_V(2); PG8_BAR;
        PG8_STAGE(PG8_SB(1, 0), cB + kstep, voffB); PG8_STAGE(PG8_SA(1, 0), cA + kstep, voffA); PG8_STAGE(PG8_SB(1, 1), cB + hstep + kstep, voffB);
        PG8_WAIT_V(6); PG8_BAR;
    } else {
        PG8_STAGE(PG8_SB(0, 0), cB, voffB); PG8_STAGE(PG8_SA(0, 0), cA, voffA); PG8_STAGE(PG8_SB(0, 1), cB + hstep, voffB); PG8_STAGE(PG8_SA(0, 1), cA + hstep, voffA);
        if (wr == 1) PG8_BAR;
        PG8_WAIT_V(4); PG8_BAR;
        PG8_STAGE(PG8_SB(1, 0), cB + kstep, voffB); PG8_STAGE(PG8_SA(1, 0), cA + kstep, voffA); PG8_STAGE(PG8_SB(1, 1), cB + hstep + kstep, voffB);
        PG8_WAIT_V(6); PG8_BAR;
    }
    for (;;) {
        const bool has_next = S.next(ui + 1, nxt);
        const char* nA = has_next ? (const char*)g.A + (size_t)nxt.pm * tstep : cA; const char* nB = has_next ? (const char*)g.Bt + (size_t)nxt.pn * tstep : cB;
        for (int t = 0; t < nt; t += 2) {
            const bool last = (t == nt - 2);
            const char* a1 = cA + (size_t)(t + 1) * kstep;
            const char* a2 = last ? nA : cA + (size_t)(t + 2) * kstep; const char* b2 = last ? nB : cB + (size_t)(t + 2) * kstep;
            const char* a3 = a2 + kstep; const char* b3 = b2 + kstep;
            if (last && has_next) S.a_ready(nxt);
            if constexpr (SP2) {
            PG8_LDB(B0, 0, 0); PG8_LDB(B1, 0, 1); PG8_SCHED; PG8_LDA(At, 0, 0); PG8_STAGE(PG8_SA(1, 1), a1 + hstep, voffA);
            PG8_WAIT_V(8); PG8_WAIT_L(0); PG8_BAR; PG8_MMA(0, 0, At, B0); PG8_MMA(0, 1, At, B1); PG8_BAR; PG8_SCHED;
            PG8_LDA(At, 0, 1); PG8_STAGE(PG8_SB(0, 0), b2, voffB); PG8_STAGE(PG8_SB(0, 1), b2 + hstep, voffB); PG8_STAGE(PG8_SA(0, 0), a2, voffA);
            PG8_WAIT_V(8); PG8_WAIT_L(0); PG8_BAR; PG8_MMA(1, 0, At, B0); PG8_MMA(1, 1, At, B1); PG8_BAR; PG8_SCHED;
            PG8_LDB(B0, 1, 0); PG8_LDB(B1, 1, 1); PG8_SCHED; PG8_LDA(At, 1, 0); PG8_STAGE(PG8_SA(0, 1), a2 + hstep, voffA);
            PG8_WAIT_V(8); PG8_WAIT_L(0); PG8_BAR; PG8_MMA(0, 0, At, B0); PG8_MMA(0, 1, At, B1); PG8_BAR; PG8_SCHED;
            PG8_LDA(At, 1, 1); PG8_STAGE(PG8_SB(1, 0), b3, voffB); PG8_STAGE(PG8_SB(1, 1), b3 + hstep, voffB); PG8_STAGE(PG8_SA(1, 0), a3, voffA);
            PG8_WAIT_V(8); PG8_WAIT_L(0); PG8_BAR; PG8_MMA(1, 0, At, B0); PG8_MMA(1, 1, At, B1); PG8_BAR; PG8_SCHED;
            } else {
            PG8_LDB(B0, 0, 0); PG8_SCHED; PG8_LDA(At, 0, 0); PG8_STAGE(PG8_SA(1, 1), a1 + hstep, voffA);
            PG8_WAIT_L(8); PG8_BAR; PG8_WAIT_L(0); PG8_MMA(0, 0, At, B0); PG8_BAR; PG8_SCHED;
            PG8_LDB(B1, 0, 1); PG8_STAGE(PG8_SB(0, 0), b2, voffB);
            PG8_BAR; PG8_WAIT_L(0); PG8_MMA(0, 1, At, B1); PG8_BAR;
            PG8_LDA(At, 0, 1); PG8_STAGE(PG8_SA(0, 0), a2, voffA);
            PG8_BAR; PG8_WAIT_L(0); PG8_MMA(1, 0, At, B0); PG8_BAR; PG8_SCHED;
            PG8_STAGE(PG8_SB(0, 1), b2 + hstep, voffB);
            PG8_WAIT_V(6); PG8_BAR; PG8_MMA(1, 1, At, B1); PG8_BAR;
            PG8_LDB(B0, 1, 0); PG8_SCHED; PG8_LDA(At, 1, 0); PG8_STAGE(PG8_SA(0, 1), a2 + hstep, voffA);
            PG8_WAIT_L(8); PG8_BAR; PG8_WAIT_L(0); PG8_MMA(0, 0, At, B0); PG8_BAR; PG8_SCHED;
            PG8_LDB(B1, 1, 1); PG8_STAGE(PG8_SB(1, 0), b3, voffB);
            PG8_BAR; PG8_WAIT_L(0); PG8_MMA(0, 1, At, B1); PG8_BAR;
            PG8_LDA(At, 1, 1); PG8_STAGE(PG8_SA(1, 0), a3, voffA);
            PG8_BAR; PG8_WAIT_L(0); PG8_MMA(1, 0, At, B0); PG8_BAR; PG8_SCHED;
            PG8_STAGE(PG8_SB(1, 1), b3 + hstep, voffB);
            PG8_WAIT_V(6); PG8_BAR; PG8_MMA(1, 1, At, B1); PG8_BAR;
            }
        }
        if constexpr (ALIGN_EPI) { if (wr == 0) PG8_BAR; }
        if constexpr (!Epi::AFTER_DRAIN) { E(acc, cur, wr, wc, fr, fq); S.done(cur); }
        if (!has_next) break;
#pragma unroll
        for (int a = 0; a < 2; ++a)
#pragma unroll
            for (int b = 0; b < 2; ++b)
#pragma unroll
                for (int m = 0; m < 4; ++m)
#pragma unroll
                    for (int n = 0; n < 2; ++n) acc[a][b][m][n] = (f32x4){0.f, 0.f, 0.f, 0.f};
        cur = nxt; cA = nA; cB = nB; ++ui;
        if constexpr (ALIGN_EPI) { if (wr == 1) PG8_BAR; }
    }
    PG8_WAIT_V(0);
    if constexpr (!ALIGN_EPI) { if (wr == 0) PG8_BAR; }
    PG8_BAR;
    if constexpr (Epi::AFTER_DRAIN) { E.fused(acc, cur, wr, wc, fr, fq, lds, wid, lane); S.done(cur); }
#undef PG8_SA
#undef PG8_SB
#undef PG8_STAGE
#undef PG8_LDA
#undef PG8_LDB
#undef PG8_MMA
#undef PG8_WAIT_V
#undef PG8_WAIT_L
#undef PG8_BAR
#undef PG8_SCHED
}

}

constexpr int NB = 8, T = 4096, M = NB * T, D = 1024, DIN = 1992, NIN = 2560, MIXK = 1536, FF = 4096, MEML = 256, MROWS = NB * MEML;
constexpr int RAWT = 7;
constexpr float LN_EPS = 1e-5f, DN_ALPHA = 1.189207115002721f;
constexpr float NEG_INF = -1e30f;
constexpr size_t MiB = 1u << 20;
constexpr size_t WS_CTL = 0, CTL_BYTES = 1 * MiB;
constexpr size_t WS_RELB = 1 * MiB;
constexpr size_t WS_BINP = 1 * MiB + 65536;
constexpr size_t WS_BT_IN = 2 * MiB, WS_BT_O = 7 * MiB, WS_BT_Q = 10 * MiB, WS_BT_KV = 12 * MiB, WS_BT_WO = 16 * MiB, WS_BT_UP = 18 * MiB, WS_BT_DN = 26 * MiB;
constexpr size_t WS_MEM16 = 34 * MiB, WS_KVM = 38 * MiB;
constexpr size_t WS_X16 = 48 * MiB, WS_MIX = 112 * MiB, WS_H = 208 * MiB, WS_RAW = 368 * MiB, WS_SCR = 368 * MiB, WS_CB = 496 * MiB, WS_IK = 504 * MiB, WS_IW = 508 * MiB;
constexpr size_t WS_Q2 = 208 * MiB, WS_O2 = 272 * MiB, WS_HFF = 208 * MiB, WS_END = 510 * MiB;

typedef unsigned short h16;
typedef _Float16 f16;
typedef _Float16 f16x2 __attribute__((ext_vector_type(2)));
typedef _Float16 f16x4 __attribute__((ext_vector_type(4)));
typedef _Float16 f16x8 __attribute__((ext_vector_type(8)));
typedef float f32x4 __attribute__((ext_vector_type(4)));
typedef float f32x2 __attribute__((ext_vector_type(2)));
typedef unsigned u32x4 __attribute__((ext_vector_type(4)));
typedef unsigned u32x2 __attribute__((ext_vector_type(2)));
#define LAS __attribute__((address_space(3)))
typedef float f32x16 __attribute__((ext_vector_type(16)));
typedef short v4i16 __attribute__((ext_vector_type(4)));
typedef short v8i16 __attribute__((ext_vector_type(8)));
typedef unsigned short u16x8 __attribute__((ext_vector_type(8)));
__device__ __forceinline__ unsigned off_b(unsigned row, unsigned ch) { return 256u * row + 16u * (ch ^ (((row & 3) << 2) | ((row >> 2) & 3))); }
__device__ __forceinline__ unsigned tr_addr16(unsigned lane, unsigned c, unsigned t) { const unsigned g = lane >> 4, q = (lane & 15) >> 2, p = lane & 3; return off_b(8 * g + 4 * t + q, 2 * c + (p >> 1)) + 8 * (p & 1); }

__device__ const unsigned char REL_BUCKET[129] = {0, 1, 2, 3, 4, 5, 6, 7, 8, 9, 10, 11, 12, 13, 14, 15, 16, 16, 16, 17, 17, 18, 18, 18, 19, 19, 19, 20, 20, 20, 20, 21, 21, 21, 21, 22, 22, 22, 22, 22, 23, 23, 23, 23, 23, 23, 24, 24, 24, 24, 24, 24, 25, 25, 25, 25, 25, 25, 25, 26, 26, 26, 26, 26, 26, 26, 26, 27, 27, 27, 27, 27, 27, 27, 27, 27, 27, 28, 28, 28, 28, 28, 28, 28, 28, 28, 28, 29, 29, 29, 29, 29, 29, 29, 29, 29, 29, 29, 29, 30, 30, 30, 30, 30, 30, 30, 30, 30, 30, 30, 30, 30, 30, 31, 31, 31, 31, 31, 31, 31, 31, 31, 31, 31, 31, 31, 31, 31, 31};

struct Params { const float* in[31]; float* out; unsigned char* ws; };
enum { I_X = 0, I_MEM, I_LNE_G, I_LNE_B, I_W_IN, I_B_IN, I_SINKS, I_KVN_G, I_W_UK, I_W_UV, I_IKLN_G, I_IKLN_B, I_REL, I_W_O, I_B_O, I_LN1_G, I_LN1_B, I_WQ, I_BQ, I_WKV, I_BKV, I_WO, I_BO,
       I_LN2_G, I_LN2_B, I_W_UP, I_B_UP, I_W_DN, I_B_DN, I_LN3_G, I_LN3_B };

__device__ __forceinline__ float wave_sum(float v) {
#pragma unroll
    for (int o = 1; o < 64; o <<= 1) v += __shfl_xor(v, o);
    return v;
}
__device__ __forceinline__ float wave_max(float v) {
#pragma unroll
    for (int o = 1; o < 64; o <<= 1) v = fmaxf(v, __shfl_xor(v, o));
    return v;
}
__device__ __forceinline__ int wave_sum_i(int v) {
#pragma unroll
    for (int o = 1; o < 64; o <<= 1) v += __shfl_xor(v, o);
    return v;
}
__device__ __forceinline__ unsigned pk2h(float lo, float hi) { return pg8::pk_f16(lo, hi); }
__device__ __forceinline__ float ld_sc1(const float* p) { return __hip_atomic_load(p, __ATOMIC_RELAXED, __HIP_MEMORY_SCOPE_AGENT); }

__device__ __forceinline__ void p0_transpose_item(const float* W, int ldw, int col0, h16* WT, int ldd, int row0, int nblk, LAS float* scr, int item, int lane) {
    const int kb = item / nblk, nb = item % nblk, k0 = 64 * kb, n0 = 32 * nb;
#pragma unroll 8
    for (int i = 0; i < 32; ++i) { const int kk = 2 * i + (lane >> 5); scr[kk * 33 + (lane & 31)] = W[(size_t)(k0 + kk) * ldw + col0 + n0 + (lane & 31)]; }
    asm volatile("s_waitcnt lgkmcnt(0)" ::: "memory");
    const int c = lane & 7;
#pragma unroll
    for (int j = 0; j < 4; ++j) { const int n = (lane >> 3) + 8 * j; const LAS float* s = scr + (8 * c) * 33 + n;
        u32x4 o; o.x = pk2h(s[0 * 33], s[1 * 33]); o.y = pk2h(s[2 * 33], s[3 * 33]); o.z = pk2h(s[4 * 33], s[5 * 33]); o.w = pk2h(s[6 * 33], s[7 * 33]);
        *(u32x4*)(WT + (size_t)(row0 + n0 + n) * ldd + k0 + 8 * c) = o; }
    asm volatile("s_waitcnt lgkmcnt(0)" ::: "memory");
}

template <bool OUT16> __device__ __forceinline__ void ln_row(const float* xrow, const float* g, const float* b, void* orow, int lane) {
    const f32x4* xr = (const f32x4*)xrow + lane;
    f32x4 v[4]; float s = 0.f;
#pragma unroll
    for (int j = 0; j < 4; ++j) { v[j] = xr[64 * j]; s += (v[j].x + v[j].y) + (v[j].z + v[j].w); }
    const float mean = wave_sum(s) * (1.f / D); float s2 = 0.f;
#pragma unroll
    for (int j = 0; j < 4; ++j) { v[j] = v[j] - mean; s2 += (v[j].x * v[j].x + v[j].y * v[j].y) + (v[j].z * v[j].z + v[j].w * v[j].w); }
    const float rstd = 1.f / sqrtf(wave_sum(s2) * (1.f / D) + LN_EPS);
#pragma unroll
    for (int j = 0; j < 4; ++j) { const f32x4 gg = ((const f32x4*)g)[lane + 64 * j], bb = ((const f32x4*)b)[lane + 64 * j]; const f32x4 o = v[j] * rstd * gg + bb;
        if (OUT16) { u32x2 w; w.x = pk2h(o.x, o.y); w.y = pk2h(o.z, o.w); ((u32x2*)orow)[lane + 64 * j] = w; }
        else ((f32x4*)orow)[lane + 64 * j] = o; }
}

__device__ __forceinline__ unsigned mono_key(float f) { unsigned b = __float_as_uint(f); if (b == 0x80000000u) b = 0u; return b ^ ((unsigned)((int)b >> 31) | 0x80000000u); }
__device__ __forceinline__ int wave_sum_dpp(int c) {
    int x = c;
    x += __builtin_amdgcn_update_dpp(0, x, 0x111, 0xf, 0xf, false);
    x += __builtin_amdgcn_update_dpp(0, x, 0x112, 0xf, 0xf, false);
    x += __builtin_amdgcn_update_dpp(0, x, 0x114, 0xf, 0xf, false);
    x += __builtin_amdgcn_update_dpp(0, x, 0x118, 0xf, 0xf, false);
    x += __builtin_amdgcn_update_dpp(0, x, 0x142, 0xa, 0xf, false);
    x += __builtin_amdgcn_update_dpp(0, x, 0x143, 0xc, 0xf, false);
    return __builtin_amdgcn_readlane(x, 63);
}
__device__ __forceinline__ int count_ge(const unsigned (&u)[64], unsigned cand, int ngrp) {
    int c = 0;
#pragma unroll
    for (int gq = 0; gq < 4; ++gq) if (gq < ngrp) {
#pragma unroll
        for (int jj = 0; jj < 16; ++jj) c += (u[gq * 16 + jj] >= cand) ? 1 : 0; }
    return wave_sum_dpp(c);
}
__device__ __forceinline__ int select_topk(const unsigned (&u)[64], int n, int ngrp, LAS unsigned short* idx, int lane) {
    unsigned th = 0u; int need = 0;
    if (n > 256) {
        unsigned lo = 0u; bool exact = false;
        for (int bit = 31; bit >= 0; --bit) {
            const unsigned cand = lo | (1u << bit); const int c = count_ge(u, cand, ngrp);
            if (c == 256) { th = cand - 1u; need = 0; exact = true; break; }
            if (c > 256) lo = cand;
        }
        if (!exact) { th = lo; need = 256 - count_ge(u, lo + 1u, ngrp); }
    }
    int base = 0, tie_seen = 0;
    const unsigned long long lt = (1ull << lane) - 1ull;
#pragma unroll
    for (int gq = 0; gq < 4; ++gq) if (gq < ngrp) {
#pragma unroll
        for (int jj = 0; jj < 16; ++jj) {
            const int j = gq * 16 + jj;
            const bool gt = u[j] > th; const bool eq = (need > 0) && (u[j] == th);
            const unsigned long long meq = __ballot(eq);
            const int eq_rank = tie_seen + __popcll(meq & lt);
            const bool sel = gt || (eq && eq_rank < need);
            const unsigned long long msel = __ballot(sel);
            const int pos = base + __popcll(msel & lt);
            if (sel) idx[pos] = (unsigned short)(64 * j + lane);
            base += __popcll(msel); tie_seen += __popcll(meq);
        } }
    return base;
}

#define XB_TMO      128
#define XB_XCNT(j)  (256  + 64 * (j))
#define XB_XSUB(j)  (1280 + 64 * (j))
#define XB_XGEN(j)  (2304 + 64 * (j))
#define XB_TOP      3328
#define XB_TOPGEN   3392
#define XCD_BAR_WORDS 3456
#define XB_SPIN_CAP (1u << 18)

__device__ __forceinline__ unsigned xb_ld(unsigned* p)              { return __hip_atomic_load(p, __ATOMIC_RELAXED, __HIP_MEMORY_SCOPE_AGENT); }
__device__ __forceinline__ unsigned xb_add(unsigned* p, unsigned v) { return __hip_atomic_fetch_add(p, v, __ATOMIC_RELAXED, __HIP_MEMORY_SCOPE_AGENT); }
__device__ __forceinline__ unsigned xb_xcc_id() { return (unsigned)__builtin_amdgcn_s_getreg((3 << 11) | 20) & 0xFu; }
#define XB_SPIN(cond, bar) do { unsigned _sp = 0; while (cond) { __builtin_amdgcn_s_sleep(1); \
    if ((++_sp & 255u) == 0u) { if (xb_ld(&(bar)[XB_TMO])) break; if (_sp > XB_SPIN_CAP) { atomicAdd(&(bar)[XB_TMO], 1u); break; } } } } while (0)

struct XcdBarrier {
    unsigned* bar; unsigned x;
    volatile LAS unsigned* st;
};

__device__ __forceinline__ XcdBarrier xcd_barrier_post(unsigned* bar, volatile LAS unsigned* st) {
    XcdBarrier b; b.bar = bar; b.x = xb_xcc_id(); b.st = st;
    if (threadIdx.x == 0) (void)xb_add(&bar[XB_XCNT(b.x)], 1u);
    return b;
}
__device__ __forceinline__ void xcd_barrier_complete(unsigned* bar, unsigned x, unsigned& nloc, unsigned& nx) {
    const unsigned G = gridDim.x * gridDim.y * gridDim.z;
    unsigned sum, cnt, mine, sp = 0u;
    for (;;) {
        sum = 0u; cnt = 0u; mine = 0u;
#pragma unroll
        for (unsigned j = 0; j < 16; ++j) { const unsigned c = xb_ld(&bar[XB_XCNT(j)]); sum += c; cnt += (c > 0u) ? 1u : 0u; mine = (j == x) ? c : mine; }
        if (sum == G) break;
        __builtin_amdgcn_s_sleep(1);
        if ((++sp & 255u) == 0u) { if (xb_ld(&bar[XB_TMO])) break; if (sp > XB_SPIN_CAP) { atomicAdd(&bar[XB_TMO], 1u); break; } }
    }
    nloc = mine > 0u ? mine : 1u; nx = cnt > 0u ? cnt : 1u;
}

__device__ __forceinline__ void xcd_barrier(const XcdBarrier& b) {
    asm volatile("s_waitcnt vmcnt(0)" ::: "memory");
    __syncthreads();
    if (threadIdx.x == 0) {
        unsigned* bar = b.bar;
        __builtin_amdgcn_s_waitcnt(0);
        unsigned nloc = b.st[0], nx = b.st[1];
        if (nloc == 0u) { xcd_barrier_complete(bar, b.x, nloc, nx); b.st[0] = nloc; b.st[1] = nx; }
        const unsigned old = xb_add(&bar[XB_XSUB(b.x)], 1u);
        const unsigned gen = old / nloc;
        if (old + 1u == (gen + 1u) * nloc) {
            __builtin_amdgcn_fence(__ATOMIC_RELEASE, "agent");
            asm volatile("s_waitcnt vmcnt(0)" ::: "memory");
            const unsigned og = xb_add(&bar[XB_TOP], 1u);
            const unsigned tg = og / nx;
            if (og + 1u == (tg + 1u) * nx) xb_add(&bar[XB_TOPGEN], 1u);
            else XB_SPIN(xb_ld(&bar[XB_TOPGEN]) == tg, bar);
            __builtin_amdgcn_fence(__ATOMIC_ACQUIRE, "agent");
            xb_add(&bar[XB_XGEN(b.x)], 1u);
            asm volatile("s_waitcnt vmcnt(0)" ::: "memory");
        } else {
            XB_SPIN(xb_ld(&bar[XB_XGEN(b.x)]) == gen, bar);
            __builtin_amdgcn_fence(__ATOMIC_ACQUIRE, "agent");
            asm volatile("s_waitcnt vmcnt(0)" ::: "memory");
        }
    }
    __syncthreads();
}

#ifndef PHM
#define PHM 0xFFFF
#endif
constexpr int NWAVES = 8, NTHREADS = 512;
constexpr int LDS_BYTES = 147456;

__global__ void __launch_bounds__(NTHREADS, 2) fwd_kernel(Params p) {
    extern __shared__ __attribute__((aligned(16))) unsigned char lds_raw[];
    LAS unsigned char* lds = (LAS unsigned char*)lds_raw;
    int tid = threadIdx.x, lane = tid & 63; const int wave = __builtin_amdgcn_readfirstlane(tid >> 6);
    volatile LAS unsigned* MISC = (volatile LAS unsigned*)(lds + LDS_BYTES - 256);
    if (tid < 64) MISC[tid] = 0u;
    __syncthreads();
    const XcdBarrier xbar = xcd_barrier_post((unsigned*)(p.ws + WS_CTL) + 4096, MISC + 8);
#define GSYNC() do { xcd_barrier(xbar); asm volatile("" : "+v"(lane), "+v"(tid)); } while (0)
    const int G = gridDim.x, gw = blockIdx.x * NWAVES + wave, NGW = G * NWAVES;
    unsigned char* ws = p.ws;
    float* RELB = (float*)(ws + WS_RELB); float* BINP = (float*)(ws + WS_BINP);
    h16* BT_IN = (h16*)(ws + WS_BT_IN); h16* BT_O = (h16*)(ws + WS_BT_O); h16* BT_Q = (h16*)(ws + WS_BT_Q); h16* BT_KV = (h16*)(ws + WS_BT_KV);
    h16* BT_WO = (h16*)(ws + WS_BT_WO); h16* BT_UP = (h16*)(ws + WS_BT_UP); h16* BT_DN = (h16*)(ws + WS_BT_DN);
    h16* MEM16 = (h16*)(ws + WS_MEM16); h16* KM = (h16*)(ws + WS_KVM); h16* VT = (h16*)(ws + WS_KVM + 4 * MiB); h16* X16 = (h16*)(ws + WS_X16); h16* MIX = (h16*)(ws + WS_MIX); h16* H = (h16*)(ws + WS_H);
    float* RAW = (float*)(ws + WS_RAW); h16* CB = (h16*)(ws + WS_CB); h16* IK16 = (h16*)(ws + WS_IK); float* IW = (float*)(ws + WS_IW); float* SCR = (float*)(ws + WS_SCR);
    h16* Q2 = (h16*)(ws + WS_Q2); h16* O2 = (h16*)(ws + WS_O2); h16* HFF = (h16*)(ws + WS_HFF);
    float* PRE = p.out;

    if (PHM & 1) {
        LAS float* scr = (LAS float*)(lds + wave * 16384);
        const float* W_IN = p.in[I_W_IN];
        constexpr int J0 = 16 * 16, J1 = 16 * 8, J2 = 16 * 4, J3 = 16 * 2, J4 = 16 * 16, J5 = 8 * 32, J6 = 16 * 32, J7 = 16 * 64, J8 = 16 * 32, J9 = 16 * 128, J10 = 64 * 32;
        constexpr int NIT = J0 + J1 + J2 + J3 + J4 + J5 + J6 + J7 + J8 + J9 + J10;
        for (int it = gw; it < NIT; it += NGW) {
            int r = it;
            if (r < J0) { p0_transpose_item(W_IN, DIN, 0, BT_IN, D, 0, 16, scr, r, lane); continue; } r -= J0;
            if (r < J1) { p0_transpose_item(W_IN, DIN, 512, BT_IN, D, 512, 8, scr, r, lane); continue; } r -= J1;
            if (r < J2) { p0_transpose_item(W_IN, DIN, 1280, BT_IN, D, 1792, 4, scr, r, lane); continue; } r -= J2;
            if (r < J3) { p0_transpose_item(W_IN, DIN, 1920, BT_IN, D, 1920, 2, scr, r, lane); continue; } r -= J3;
            if (r < J4) { p0_transpose_item(W_IN, DIN, 1408, BT_IN, D, 2048, 16, scr, r, lane); continue; } r -= J4;
            if (r < J5) { p0_transpose_item(p.in[I_W_O], D, 0, BT_O, MIXK, 0, 32, scr, r, lane); continue; } r -= J5;
            if (r < J6) { p0_transpose_item(p.in[I_WQ], D, 0, BT_Q, D, 0, 32, scr, r, lane); continue; } r -= J6;
            if (r < J7) { p0_transpose_item(p.in[I_WKV], 2 * D, 0, BT_KV, D, 0, 64, scr, r, lane); continue; } r -= J7;
            if (r < J8) { p0_transpose_item(p.in[I_WO], D, 0, BT_WO, D, 0, 32, scr, r, lane); continue; } r -= J8;
            if (r < J9) { p0_transpose_item(p.in[I_W_UP], FF, 0, BT_UP, D, 0, 128, scr, r, lane); continue; } r -= J9;
            p0_transpose_item(p.in[I_W_DN], D, 0, BT_DN, FF, 0, 32, scr, r, lane);
        }
        const float* WUK = p.in[I_W_UK]; const float* WUV = p.in[I_W_UV]; const float* W_O = p.in[I_W_O];
        for (int it = gw; it < 1024 * 16; it += NGW) {
            const int n = it >> 4, k = ((it & 15) << 6) + lane, h = n >> 7;
            const float* wr = W_IN + (size_t)k * DIN + 768 + 64 * h; const float* ur = WUK + (size_t)n * 64;
            float a = 0.f;
#pragma unroll 8
            for (int d = 0; d < 64; ++d) a += wr[d] * ur[d];
            ((f16*)BT_IN)[(size_t)(768 + n) * D + k] = (f16)(a * 0.125f);
        }
        for (int it = gw; it < 1024 * 16; it += NGW) {
            const int n = it >> 4, j = ((it & 15) << 6) + lane, h = j >> 7;
            const float* vr = WUV + (size_t)j * 64; const float* orow = W_O + (size_t)(512 + 64 * h) * D + n;
            float a = 0.f;
#pragma unroll 8
            for (int d = 0; d < 64; ++d) a += vr[d] * orow[(size_t)d * D];
            ((f16*)BT_O)[(size_t)n * MIXK + 512 + j] = (f16)a;
        }
        for (int it = gw; it < 64 * 16; it += NGW) {
            const int r = it >> 4, k = ((it & 15) << 6) + lane;
            const float v = (r < 8) ? W_IN[(size_t)k * DIN + 1984 + r] : 0.f;
            ((f16*)BT_IN)[(size_t)(1984 + r) * D + k] = (f16)v;
        }
        const float* B_IN = p.in[I_B_IN];
        for (int n = gw * 64 + lane; n < NIN; n += NGW * 64) {
            float v;
            if (n < 768) v = B_IN[n];
            else if (n < 1792) { const int j = n - 768, h = j >> 7; float a = 0.f; for (int d = 0; d < 64; ++d) a += B_IN[768 + 64 * h + d] * WUK[(size_t)j * 64 + d]; v = a * 0.125f; }
            else if (n < 1920) v = B_IN[1280 + (n - 1792)];
            else if (n < 1992) v = B_IN[n];
            else if (n < 2048) v = 0.f;
            else v = B_IN[1408 + (n - 2048)];
            BINP[n] = v;
        }
        const float* REL = p.in[I_REL];
        for (int i = gw * 64 + lane; i < 16 * 132; i += NGW * 64) { const int h = i / 132, d = i % 132; RELB[i] = REL[(int)REL_BUCKET[d > 128 ? 128 : d] * 16 + h]; }
        const float* MEMF = p.in[I_MEM];
        for (int i = gw * 64 + lane; i < MROWS * D / 4; i += NGW * 64) { const f32x4 v = ((const f32x4*)MEMF)[i]; u32x2 w; w.x = pk2h(v.x, v.y); w.y = pk2h(v.z, v.w); ((u32x2*)MEM16)[i] = w; }
        for (int m = gw; m < M; m += NGW) ln_row<true>(p.in[I_X] + (size_t)m * D, p.in[I_LNE_G], p.in[I_LNE_B], X16 + (size_t)m * D, lane);
    }
    GSYNC();

    if (PHM & 2) {
        pg8::Gemm g{X16, BT_IN, M, NIN, D}; pg8::StaticOrder S; S.init(M, NIN, G, (int)blockIdx.x);
        pg8::EpiIn E{H, NIN, BINP, RAW, RAWT};
        pg8::gemm_phase<pg8::EpiIn, pg8::StaticOrder, true, true>(lds, g, S, E);
    }
    if (PHM & 4) {
        pg8::Gemm g{MEM16, BT_KV, MROWS, 2 * D, D}; pg8::StaticOrder S; S.init(MROWS, 2 * D, G, (int)blockIdx.x);
        pg8::EpiKV E{KM, VT, p.in[I_BKV]};
        pg8::gemm_phase<pg8::EpiKV, pg8::StaticOrder, true, true>(lds, g, S, E);
    }
    GSYNC();

    if (PHM & 8) {
        const float* KG = p.in[I_KVN_G]; const float* IG = p.in[I_IKLN_G]; const float* IB = p.in[I_IKLN_B];
        for (int m = gw; m < M; m += NGW) {
            const float* r = RAW + (size_t)m * 256;
            const float c0 = r[lane], c1 = r[64 + lane];
            const float rr = 1.f / sqrtf(wave_sum(c0 * c0 + c1 * c1) * (1.f / 128.f) + LN_EPS);
            ((f16*)CB)[(size_t)m * 128 + lane] = (f16)(c0 * rr * KG[lane]); ((f16*)CB)[(size_t)m * 128 + 64 + lane] = (f16)(c1 * rr * KG[64 + lane]);
            const float k = r[128 + lane]; const float mu = wave_sum(k) * (1.f / 64.f); const float dk = k - mu;
            const float rs = 1.f / sqrtf(wave_sum(dk * dk) * (1.f / 64.f) + LN_EPS);
            ((f16*)IK16)[(size_t)m * 64 + lane] = (f16)(dk * rs * IG[lane] + IB[lane]);
            if (lane < 8) IW[(size_t)m * 8 + lane] = r[192 + lane] * (0.35355339059327373f * 0.125f);
        }
    }
    GSYNC();

    if (PHM & 32) {
        LAS unsigned short* idx_all = (LAS unsigned short*)(lds + 65536);
        LAS float* relb_s = (LAS float*)(lds + 65536 + 16384);
        LAS int* s_item = (LAS int*)(lds + 65536 + 16384 + 4224);
        LAS float* rba_s = (LAS float*)(lds + 86400);
        for (int i = tid; i < 8 * 132; i += NTHREADS) relb_s[i] = RELB[8 * 132 + i];
        for (int i = tid; i < 8 * 128; i += NTHREADS) rba_s[i] = RELB[(i >> 7) * 132 + (i & 127)];
        float* SCRW = SCR + (size_t)blockIdx.x * (32 * 4096);
        unsigned* qctr = (unsigned*)(ws + WS_CTL) + 64;
        for (;;) {
            __syncthreads();
            if (tid == 0) *s_item = (int)atomicAdd(qctr, 1u);
            __syncthreads();
            const int item = *s_item;
            if (item >= NB * 128 + 512) break;
            if (item >= NB * 128) {
                const int unit = item - NB * 128, kvh = unit & 1, n = (unit >> 1) & 31, b = unit >> 6;
                LAS unsigned char* Ks = lds;
                LAS unsigned char* Vt = lds + 32768;
                asm volatile("" : "+v"(lane), "+v"(tid));
#pragma unroll
                for (int i = 0; i < 4; ++i) {
                    const int pz = tid + 512 * i, r = pz >> 3, ch = pz & 7;
                    u32x4 kv = (u32x4){0u, 0u, 0u, 0u}, vv = (u32x4){0u, 0u, 0u, 0u};
                    if (n > 0 || r >= 128) { const f16* src = (const f16*)H + (size_t)(b * T + 128 * (n - 1) + r) * NIN + 512 + kvh * 64 + 8 * ch; kv = *(const u32x4*)src; vv = *(const u32x4*)(src + 128); }
                    *(LAS u32x4*)(Ks + r * 128 + ((ch ^ ((r >> 1) & 7)) << 4)) = kv;
                    LAS unsigned short* vd = (LAS unsigned short*)(Vt + (8 * ch) * 520 + r * 2);
                    vd[0 * 260] = (unsigned short)(vv.x & 0xffffu); vd[1 * 260] = (unsigned short)(vv.x >> 16); vd[2 * 260] = (unsigned short)(vv.y & 0xffffu); vd[3 * 260] = (unsigned short)(vv.y >> 16);
                    vd[4 * 260] = (unsigned short)(vv.z & 0xffffu); vd[5 * 260] = (unsigned short)(vv.z >> 16); vd[6 * 260] = (unsigned short)(vv.w & 0xffffu); vd[7 * 260] = (unsigned short)(vv.w >> 16);
                }
                __syncthreads();
                const int c = lane & 31, hi = lane >> 5, hd = 4 * kvh + (wave & 3), qhalf = wave >> 2;
                const float sink = p.in[I_SINKS][hd];
                const LAS float* rbh = rba_s + hd * 128;
#pragma unroll 1
                for (int sb = 0; sb < 2; ++sb) {
                    const int j0 = 2 * qhalf + sb, q0 = 32 * j0;
                    const size_t mrow = (size_t)(b * T + 128 * n + q0 + c);
                    f16x8 qf[4];
#pragma unroll
                    for (int ks = 0; ks < 4; ++ks) qf[ks] = *(const f16x8*)((const f16*)H + mrow * NIN + hd * 64 + 16 * ks + 8 * hi);
                    f32x16 S[5];
#pragma unroll
                    for (int jt = 0; jt < 5; ++jt) {
#pragma unroll
                        for (int r = 0; r < 16; ++r) S[jt][r] = 0.f;
#pragma unroll
                        for (int ks = 0; ks < 4; ++ks) {
                            const f16x8 a = *(const LAS f16x8*)(Ks + (32 * (j0 + jt) + c) * 128 + (((2 * ks + hi) ^ ((c >> 1) & 7)) << 4));
                            S[jt] = __builtin_amdgcn_mfma_f32_32x32x16_f16(a, qf[ks], S[jt], 0, 0, 0);
                        }
                    }
                    float mx = sink;
#pragma unroll
                    for (int jt = 0; jt < 5; ++jt)
#pragma unroll
                        for (int r = 0; r < 16; ++r) {
                            const int si = 32 * (j0 + jt) + (r & 3) + 8 * (r >> 2) + 4 * hi; const int rel = q0 + c + 128 - si;
                            const bool valid = (rel >= 0) && (rel < 128) && (n > 0 || si >= 128);
                            const float l = valid ? S[jt][r] * 0.125f + rbh[rel & 127] : NEG_INF;
                            S[jt][r] = l; mx = fmaxf(mx, l);
                        }
                    mx = fmaxf(mx, __shfl_xor(mx, 32));
                    float sum = 0.f;
#pragma unroll
                    for (int jt = 0; jt < 5; ++jt)
#pragma unroll
                        for (int r = 0; r < 16; ++r) { const float e = __expf(S[jt][r] - mx); S[jt][r] = e; sum += e; }
                    sum += __shfl_xor(sum, 32);
                    const float inv = 1.f / (sum + __expf(sink - mx));
                    f32x16 o[2];
#pragma unroll
                    for (int dt = 0; dt < 2; ++dt)
#pragma unroll
                        for (int r = 0; r < 16; ++r) o[dt][r] = 0.f;
#pragma unroll
                    for (int jt = 0; jt < 5; ++jt)
#pragma unroll
                        for (int s = 0; s < 2; ++s) {
                            f16x8 pb;
#pragma unroll
                            for (int j = 0; j < 8; ++j) pb[j] = (f16)S[jt][8 * s + j];
#pragma unroll
                            for (int dt = 0; dt < 2; ++dt) {
                                const LAS unsigned char* vp = Vt + (32 * dt + c) * 520 + (32 * (j0 + jt) + 16 * s + 4 * hi) * 2;
                                const f16x4 v0 = *(const LAS f16x4*)vp, v1 = *(const LAS f16x4*)(vp + 16);
                                const f16x8 av = (f16x8){v0[0], v0[1], v0[2], v0[3], v1[0], v1[1], v1[2], v1[3]};
                                o[dt] = __builtin_amdgcn_mfma_f32_32x32x16_f16(av, pb, o[dt], 0, 0, 0);
                            }
                        }
                    f16* op = (f16*)MIX + mrow * MIXK + hd * 64 + 4 * hi;
#pragma unroll
                    for (int dt = 0; dt < 2; ++dt)
#pragma unroll
                        for (int rq = 0; rq < 4; ++rq) { u32x2 w; w.x = pk2h(o[dt][4 * rq] * inv, o[dt][4 * rq + 1] * inv); w.y = pk2h(o[dt][4 * rq + 2] * inv, o[dt][4 * rq + 3] * inv); *(u32x2*)(op + 32 * dt + 8 * rq) = w; }
                }
                continue;
            }
            const int qb32 = 127 - (item >> 3), b = item & 7;
            const int m0 = b * T + 32 * qb32;
            asm volatile("" : "+v"(lane));
            const int c32 = lane & 31, hi = lane >> 5;
            {
                f16x8 bq[8][4];
                const f16* iqp = (const f16*)H + (size_t)(m0 + c32) * NIN + 2048 + 8 * hi;
#pragma unroll
                for (int h = 0; h < 8; ++h)
#pragma unroll
                    for (int ks = 0; ks < 4; ++ks) bq[h][ks] = *(const f16x8*)(iqp + h * 64 + ks * 16);
                float iwv[8];
                { const f32x4 w0 = *(const f32x4*)(IW + (size_t)(m0 + c32) * 8), w1 = *(const f32x4*)(IW + (size_t)(m0 + c32) * 8 + 4);
                  iwv[0] = w0.x; iwv[1] = w0.y; iwv[2] = w0.z; iwv[3] = w0.w; iwv[4] = w1.x; iwv[5] = w1.y; iwv[6] = w1.z; iwv[7] = w1.w; }
                for (int kt = wave; kt <= qb32; kt += 8) {
                    const f16* ikp = (const f16*)IK16 + (size_t)(b * T + kt * 32 + c32) * 64 + 8 * hi;
                    f16x8 ak[4];
#pragma unroll
                    for (int ks = 0; ks < 4; ++ks) ak[ks] = *(const f16x8*)(ikp + ks * 16);
                    float sc[16];
#pragma unroll
                    for (int r = 0; r < 16; ++r) sc[r] = 0.f;
#pragma unroll
                    for (int h = 0; h < 8; ++h) {
                        f32x16 acc;
#pragma unroll
                        for (int r = 0; r < 16; ++r) acc[r] = 0.f;
#pragma unroll
                        for (int ks = 0; ks < 4; ++ks) acc = __builtin_amdgcn_mfma_f32_32x32x16_f16(ak[ks], bq[h][ks], acc, 0, 0, 0);
#pragma unroll
                        for (int r = 0; r < 16; ++r) { const int ai = __float_as_int(acc[r]); sc[r] += iwv[h] * __int_as_float(ai < 0 ? 0 : ai); }
#pragma unroll
                        for (int r = 0; r < 16; ++r) asm volatile("" : "+v"(sc[r]));
                    }
                    float* sp = SCRW + (size_t)c32 * 4096 + kt * 32 + 4 * hi;
#pragma unroll
                    for (int i = 0; i < 4; ++i) *(f32x4*)(sp + 8 * i) = (f32x4){sc[4 * i], sc[4 * i + 1], sc[4 * i + 2], sc[4 * i + 3]};
                }
            }
            asm volatile("s_waitcnt vmcnt(0)" ::: "memory");
            __syncthreads();
#pragma unroll 1
            for (int qi = 0; qi < 4; ++qi) {
                const int q = 4 * wave + qi, t = 32 * qb32 + q, m = m0 + q;
                int lane_o = lane; asm volatile("" : "+v"(lane_o));
                const int head = lane_o & 15, g = lane_o >> 4;
                LAS unsigned char* gb = lds + wave * 8192;
                LAS unsigned short* idxq = idx_all + q * 256;
                int cnt;
                {
                    unsigned u[64];
                    const float* sb = SCRW + (size_t)q * 4096 + lane; asm volatile("" : "+v"(sb));
                    const int ngrp = (t >> 10) + 1;
#pragma unroll
                    for (int gq = 0; gq < 4; ++gq) {
                        if (gq < ngrp) {
#pragma unroll
                            for (int jj = 0; jj < 16; ++jj) { const int j = gq * 16 + jj; u[j] = __float_as_uint(ld_sc1(sb + 64 * j)); }
                        } else {
#pragma unroll
                            for (int jj = 0; jj < 16; ++jj) u[gq * 16 + jj] = 0u;
                        }
                    }
#pragma unroll
                    for (int gq = 0; gq < 4; ++gq) {
                        if (gq < ngrp) {
#pragma unroll
                            for (int jj = 0; jj < 16; ++jj) { const int j = gq * 16 + jj; u[j] = (64 * j + lane <= t) ? mono_key(__uint_as_float(u[j])) : 0u; }
                        }
                    }
                    cnt = select_topk(u, t + 1, ngrp, idxq, lane);
                    for (int e = cnt + lane; e < 256; e += 64) idxq[e] = 0;
                }
                asm volatile("s_waitcnt lgkmcnt(0)" ::: "memory");
                {
                    f16x8 qf[4];
                    { const f16* qp = (const f16*)H + (size_t)m * NIN + 768 + (head & 7) * 128 + 8 * g;
#pragma unroll
                      for (int ks = 0; ks < 4; ++ks) { f16x8 v = *(const f16x8*)(qp + 32 * ks); if (head >= 8) v = (f16x8){0, 0, 0, 0, 0, 0, 0, 0}; qf[ks] = v; } }
                    const f16* cbb = (const f16*)CB + (size_t)(b * T) * 128 + (lane_o & 15) * 8;
                    u32x4 gr[2][8];
#pragma unroll
                    for (int hf = 0; hf < 2; ++hf)
#pragma unroll
                        for (int i = 0; i < 8; ++i) { const int s = (int)idxq[hf * 32 + 4 * i + g]; gr[hf][i] = *(const u32x4*)(cbb + (size_t)s * 128); }
                    float m_run = -3.0e38f, l_part = 0.f;
                    f32x4 o[8];
#pragma unroll
                    for (int ct = 0; ct < 8; ++ct) o[ct] = (f32x4){0.f, 0.f, 0.f, 0.f};
                    const int rowA0 = 8 * ((lane_o & 15) >> 2) + (lane_o & 3);
                    const LAS float* rbh = relb_s + (head & 7) * 132;
#pragma unroll 1
                    for (int cp = 0; cp < 4; ++cp) {
#pragma unroll
                      for (int hf = 0; hf < 2; ++hf) {
                        const int chunk = 2 * cp + hf;
#pragma unroll
                        for (int i = 0; i < 8; ++i) *(LAS u32x4*)(gb + off_b(4 * i + g, lane_o & 15)) = gr[hf][i];
                        if (cp < 3) {
#pragma unroll
                            for (int i = 0; i < 8; ++i) { const int s = (int)idxq[(chunk + 2) * 32 + 4 * i + g]; gr[hf][i] = *(const u32x4*)(cbb + (size_t)s * 128); }
                        }
                        f32x4 S0 = (f32x4){0.f, 0.f, 0.f, 0.f}, S1 = (f32x4){0.f, 0.f, 0.f, 0.f};
#pragma unroll
                        for (int ks = 0; ks < 4; ++ks) {
                            const f16x8 a0 = *(const LAS f16x8*)(gb + off_b(rowA0, 4 * ks + g)), a1 = *(const LAS f16x8*)(gb + off_b(rowA0 + 4, 4 * ks + g));
                            S0 = __builtin_amdgcn_mfma_f32_16x16x32_f16(a0, qf[ks], S0, 0, 0, 0);
                            S1 = __builtin_amdgcn_mfma_f32_16x16x32_f16(a1, qf[ks], S1, 0, 0, 0);
                        }
                        const u16x8 myi = *(const LAS u16x8*)(idxq + chunk * 32 + 8 * g);
                        float lg[8];
#pragma unroll
                        for (int j = 0; j < 8; ++j) { const int s = (int)myi[j]; int dist = t - s; dist = dist > 128 ? 128 : dist; const float sv = (j < 4) ? S0[j & 3] : S1[j & 3];
                            lg[j] = (chunk * 32 + 8 * g + j < cnt) ? sv + rbh[dist] : NEG_INF; }
                        float mx = fmaxf(fmaxf(fmaxf(lg[0], lg[1]), fmaxf(lg[2], lg[3])), fmaxf(fmaxf(lg[4], lg[5]), fmaxf(lg[6], lg[7])));
                        mx = fmaxf(mx, __shfl_xor(mx, 16)); mx = fmaxf(mx, __shfl_xor(mx, 32));
                        const float m_new = fmaxf(m_run, mx); const float scl = __expf(m_run - m_new); m_run = m_new;
                        float pr[8]; float ps = 0.f;
#pragma unroll
                        for (int j = 0; j < 8; ++j) { pr[j] = __expf(lg[j] - m_new); ps += pr[j]; }
                        l_part = l_part * scl + ps;
                        f16x8 pb;
#pragma unroll
                        for (int j = 0; j < 8; ++j) pb[j] = (f16)pr[j];
#pragma unroll
                        for (int ct = 0; ct < 8; ++ct) {
                            const v4i16 t0 = __builtin_amdgcn_ds_read_tr16_b64_v4i16((LAS v4i16*)(gb + tr_addr16(lane_o, ct, 0)));
                            const v4i16 t1 = __builtin_amdgcn_ds_read_tr16_b64_v4i16((LAS v4i16*)(gb + tr_addr16(lane_o, ct, 1)));
                            const v8i16 av = (v8i16){t0[0], t0[1], t0[2], t0[3], t1[0], t1[1], t1[2], t1[3]};
                            o[ct] = o[ct] * scl;
                            o[ct] = __builtin_amdgcn_mfma_f32_16x16x32_f16(__builtin_bit_cast(f16x8, av), pb, o[ct], 0, 0, 0);
                        }
                      }
                    }
                    float l_tot = l_part; l_tot += __shfl_xor(l_tot, 16); l_tot += __shfl_xor(l_tot, 32);
                    const float inv = 1.f / l_tot;
                    if (head < 8) {
                        f16* op = (f16*)MIX + (size_t)m * MIXK + 512 + head * 128 + 4 * g;
#pragma unroll
                        for (int ct = 0; ct < 8; ++ct) { u32x2 w; w.x = pk2h(o[ct][0] * inv, o[ct][1] * inv); w.y = pk2h(o[ct][2] * inv, o[ct][3] * inv); *(u32x2*)(op + 16 * ct) = w; }
                    }
                }
            }
        }
    }
    GSYNC();

    if (PHM & 64) {
        pg8::Gemm g{MIX, BT_O, M, D, MIXK}; pg8::StaticOrder S; S.init(M, D, G, (int)blockIdx.x);
        pg8::EpiPre E{X16, PRE, D, p.in[I_B_O], DN_ALPHA};
        pg8::gemm_phase<pg8::EpiPre, pg8::StaticOrder, true, true>(lds, g, S, E);
    }
    GSYNC();
    for (int m = gw; m < M; m += NGW) ln_row<true>(PRE + (size_t)m * D, p.in[I_LN1_G], p.in[I_LN1_B], X16 + (size_t)m * D, lane);
    GSYNC();

    if (PHM & 128) {
        pg8::Gemm g{X16, BT_Q, M, D, D}; pg8::StaticOrder S; S.init(M, D, G, (int)blockIdx.x);
        pg8::EpiF16<0> E{Q2, D, p.in[I_BQ]};
        pg8::gemm_phase<pg8::EpiF16<0>, pg8::StaticOrder, true, true>(lds, g, S, E);
    }
    GSYNC();

    if (PHM & 256) {
        LAS unsigned char* Ks = lds;
        LAS unsigned char* Vs = lds + 32768;
        const int q16 = lane & 15, g = lane >> 4;
        for (int unit = blockIdx.x; unit < 1024; unit += G) {
            const int qblk = unit & 31, head = (unit >> 5) & 3, b = unit >> 7;
            const size_t mrow = (size_t)b * T + qblk * 128 + wave * 16 + q16;
            f16x8 qf[8];
#pragma unroll
            for (int ks = 0; ks < 8; ++ks) qf[ks] = *(const f16x8*)((const f16*)Q2 + mrow * D + head * 256 + 32 * ks + 8 * g);
            f32x4 o[16];
#pragma unroll
            for (int dt = 0; dt < 16; ++dt) o[dt] = (f32x4){0.f, 0.f, 0.f, 0.f};
            float m_run = -3.0e38f, l_part = 0.f;
#pragma unroll 1
            for (int c = 0; c < 4; ++c) {
                __syncthreads();
#pragma unroll
                for (int i = 0; i < 4; ++i) {
                    const int pz = tid + 512 * i;
                    { const int r = pz >> 5, ch = pz & 31;
                      const u32x4 v = *(const u32x4*)((const f16*)KM + (size_t)(b * MEML + 64 * c + r) * D + head * 256 + 8 * ch);
                      *(LAS u32x4*)(Ks + r * 512 + ((ch ^ (r & 15)) << 4)) = v; }
                    { const int d = pz >> 3, pc = pz & 7;
                      const u32x4 v = *(const u32x4*)((const f16*)VT + (size_t)((b * 4 + head) * 256 + d) * MEML + 64 * c + 8 * pc);
                      *(LAS u32x4*)(Vs + d * 144 + pc * 16) = v; }
                }
                __syncthreads();
                f32x4 S[4];
#pragma unroll
                for (int u = 0; u < 4; ++u) {
                    S[u] = (f32x4){0.f, 0.f, 0.f, 0.f};
#pragma unroll
                    for (int ks = 0; ks < 8; ++ks) {
                        const f16x8 a = *(const LAS f16x8*)(Ks + (16 * u + q16) * 512 + (((4 * ks + g) ^ q16) << 4));
                        S[u] = __builtin_amdgcn_mfma_f32_16x16x32_f16(a, qf[ks], S[u], 0, 0, 0);
                    }
                }
                float mx = -3.0e38f;
#pragma unroll
                for (int u = 0; u < 4; ++u)
#pragma unroll
                    for (int r = 0; r < 4; ++r) { S[u][r] *= 0.0625f; mx = fmaxf(mx, S[u][r]); }
                mx = fmaxf(mx, __shfl_xor(mx, 16)); mx = fmaxf(mx, __shfl_xor(mx, 32));
                const float m_new = fmaxf(m_run, mx); const float scl = __expf(m_run - m_new); m_run = m_new;
                float ps = 0.f;
#pragma unroll
                for (int u = 0; u < 4; ++u)
#pragma unroll
                    for (int r = 0; r < 4; ++r) { S[u][r] = __expf(S[u][r] - m_new); ps += S[u][r]; }
                l_part = l_part * scl + ps;
                f16x8 pb[2];
#pragma unroll
                for (int v = 0; v < 2; ++v)
#pragma unroll
                    for (int j = 0; j < 4; ++j) { pb[v][j] = (f16)S[2 * v][j]; pb[v][4 + j] = (f16)S[2 * v + 1][j]; }
#pragma unroll
                for (int dt = 0; dt < 16; ++dt) {
                    o[dt] = o[dt] * scl;
#pragma unroll
                    for (int v = 0; v < 2; ++v) {
                        const LAS unsigned char* vp = Vs + (16 * dt + q16) * 144 + (32 * v + 4 * g) * 2;
                        const f16x4 v0 = *(const LAS f16x4*)vp, v1 = *(const LAS f16x4*)(vp + 32);
                        const f16x8 av = (f16x8){v0[0], v0[1], v0[2], v0[3], v1[0], v1[1], v1[2], v1[3]};
                        o[dt] = __builtin_amdgcn_mfma_f32_16x16x32_f16(av, pb[v], o[dt], 0, 0, 0);
                    }
                }
            }
            float l_tot = l_part; l_tot += __shfl_xor(l_tot, 16); l_tot += __shfl_xor(l_tot, 32);
            const float inv = 1.f / l_tot;
            f16* op = (f16*)O2 + mrow * D + head * 256 + 4 * g;
#pragma unroll
            for (int dt = 0; dt < 16; ++dt) { u32x2 w; w.x = pk2h(o[dt][0] * inv, o[dt][1] * inv); w.y = pk2h(o[dt][2] * inv, o[dt][3] * inv); *(u32x2*)(op + 16 * dt) = w; }
        }
    }
    GSYNC();

    if (PHM & 512) {
        pg8::Gemm g{O2, BT_WO, M, D, D}; pg8::StaticOrder S; S.init(M, D, G, (int)blockIdx.x);
        pg8::EpiPre E{X16, PRE, D, p.in[I_BO], DN_ALPHA};
        pg8::gemm_phase<pg8::EpiPre, pg8::StaticOrder, true, true>(lds, g, S, E);
    }
    GSYNC();
    for (int m = gw; m < M; m += NGW) ln_row<true>(PRE + (size_t)m * D, p.in[I_LN2_G], p.in[I_LN2_B], X16 + (size_t)m * D, lane);
    GSYNC();

    if (PHM & 1024) {
        pg8::Gemm g{X16, BT_UP, M, FF, D}; pg8::StaticOrder S; S.init(M, FF, G, (int)blockIdx.x);
        pg8::EpiF16<2> E{HFF, FF, p.in[I_B_UP]};
        pg8::gemm_phase<pg8::EpiF16<2>, pg8::StaticOrder, true, true>(lds, g, S, E);
    }
    GSYNC();
    if (PHM & 2048) {
        pg8::Gemm g{HFF, BT_DN, M, D, FF}; pg8::StaticOrder S; S.init(M, D, G, (int)blockIdx.x);
        pg8::EpiPre E{X16, PRE, D, p.in[I_B_DN], DN_ALPHA};
        pg8::gemm_phase<pg8::EpiPre, pg8::StaticOrder, true, true>(lds, g, S, E);
    }
    GSYNC();
    for (int m = gw; m < M; m += NGW) ln_row<false>(PRE + (size_t)m * D, p.in[I_LN3_G], p.in[I_LN3_B], p.out + (size_t)m * D, lane);
}

extern "C" void kernel_launch(void* const* d_in, const int* in_sizes, int n_in, void* d_out, int out_size, void* d_ws, size_t ws_size, hipStream_t stream) {
    static int grid = 0;
    if (grid == 0) {
        if (n_in != 31 || out_size != M * D || ws_size < WS_END) { fprintf(stderr, "kernel_launch: unexpected shapes (n_in %d, out %d, ws %zu)\n", n_in, out_size, ws_size); grid = -1; return; }
        int dev = 0, cus = 0, per_cu = 0;
        hipGetDevice(&dev); hipDeviceGetAttribute(&cus, hipDeviceAttributeMultiprocessorCount, dev);
        hipFuncSetAttribute((const void*)fwd_kernel, hipFuncAttributeMaxDynamicSharedMemorySize, LDS_BYTES);
        hipOccupancyMaxActiveBlocksPerMultiprocessor(&per_cu, (const void*)fwd_kernel, NTHREADS, LDS_BYTES);
        if (per_cu < 1) { fprintf(stderr, "kernel_launch: occupancy query says %d blocks per CU\n", per_cu); grid = -1; return; }
        grid = cus;
    }
    if (grid < 0) return;
    hipMemsetAsync((char*)d_ws + WS_CTL, 0, CTL_BYTES, stream);
    Params p{};
    for (int i = 0; i < 31; ++i) p.in[i] = (const float*)d_in[i];
    p.out = (float*)d_out; p.ws = (unsigned char*)d_ws;
    void* args[] = {&p};
    hipError_t e = hipLaunchCooperativeKernel((const void*)fwd_kernel, dim3(grid), dim3(NTHREADS), args, LDS_BYTES, stream);
    if (e != hipSuccess) fprintf(stderr, "cooperative launch failed: %s (grid %d)\n", hipGetErrorString(e), grid);
}
```

```cpp
#include <hip/hip_runtime.h>
#include <hip/hip_cooperative_groups.h>
#include <cstdio>
#include <cstdint>
namespace cg = cooperative_groups;

namespace pg8 {
#define PG8_LAS __attribute__((address_space(3)))
typedef unsigned short bf16_t;
typedef _Float16 bf16x8 __attribute__((ext_vector_type(8)));
typedef float f32x4 __attribute__((ext_vector_type(4)));
typedef unsigned u32x4 __attribute__((ext_vector_type(4)));
typedef unsigned u32x2 __attribute__((ext_vector_type(2)));
typedef float f32x2 __attribute__((ext_vector_type(2)));
typedef _Float16 f16x2 __attribute__((ext_vector_type(2)));
typedef _Float16 f16x4 __attribute__((ext_vector_type(4)));
constexpr int BM = 256, BK = 64, HALF = 128, HTB = HALF * BK * 2, STAGE_BYTES = 8 * HTB, NXCD = 8, WGM = 8;

__host__ __device__ __forceinline__ int lds_byte(int r, int c) { const int st = (r >> 4) * 2 + (c >> 5), rr = r & 15, cc = c & 31, ob = rr * 64 + cc * 2; return st * 1024 + (ob ^ (((ob >> 9) & 1) << 5)); }
__host__ __device__ __forceinline__ void stage_rc(int b, int& R, int& C) { const int st = b / 1024, sb = b % 1024, swz = sb ^ (((sb >> 9) & 1) << 5); R = (st >> 1) * 16 + swz / 64; C = (st & 1) * 32 + (swz % 64) / 2; }
__host__ __device__ __forceinline__ int perm32(int rho) { const int n = rho >> 4, i = rho & 15; return 8 * (i >> 2) + 4 * n + (i & 3); }

struct Unit { int pm, pn; };
struct Gemm { const bf16_t* A; const bf16_t* Bt; int M, N, K; };

struct StaticOrder {
    int nM, nN, nwg, G, c;
    __host__ __device__ void init(int M, int N, int G_, int c_) { nM = M / BM; nN = N / BM; nwg = nM * nN; G = G_; c = c_; }
    __host__ __device__ bool next(int i, Unit& u) const {
        const long L = (long)i * G + c; if (L >= nwg) return false;
        int wgid = (int)L; { const int q = nwg / NXCD, r = nwg % NXCD, xcd = wgid % NXCD, off = wgid / NXCD; wgid = (xcd < r ? xcd * (q + 1) : r * (q + 1) + (xcd - r) * q) + off; }
        const int nig = WGM * nN, gid = wgid / nig, fm = gid * WGM, gsz = (nM - fm) < WGM ? (nM - fm) : WGM;
        u.pm = fm + ((wgid % nig) % gsz); u.pn = (wgid % nig) / gsz; return true;
    }
    __device__ __forceinline__ void a_ready(const Unit&) const {}
    __device__ __forceinline__ void done(const Unit&) const {}
};

__device__ __forceinline__ unsigned pk_f16(float lo, float hi) { f32x2 v = {lo, hi}; f16x2 h = __builtin_convertvector(v, f16x2); return __builtin_bit_cast(unsigned, h); }

template <int ACT  > struct EpiF16 {
    static constexpr bool PERM = true, AFTER_DRAIN = false;
    bf16_t* O; int ldc; const float* bias;
    __device__ __forceinline__ void operator()(const f32x4 (&acc)[2][2][4][2], const Unit& u, int wr, int wc, int fr, int fq) const {
        const int row0 = u.pm * BM + wr * 64 + fr; const int col0 = u.pn * BM + wc * 32 + 8 * fq;
        f32x4 bv[2][2];
#pragma unroll
        for (int bj = 0; bj < 2; ++bj)
#pragma unroll
            for (int n = 0; n < 2; ++n) bv[bj][n] = *(const f32x4*)(bias + col0 + bj * HALF + 4 * n);
#pragma unroll
        for (int ai = 0; ai < 2; ++ai)
#pragma unroll
            for (int m = 0; m < 4; ++m) { bf16_t* rowp = O + (size_t)(row0 + ai * HALF + m * 16) * ldc + col0;
#pragma unroll
                for (int bj = 0; bj < 2; ++bj) { f32x4 v0 = acc[ai][bj][m][0] + bv[bj][0], v1 = acc[ai][bj][m][1] + bv[bj][1];
                    if (ACT == 2) {
#pragma unroll
                        for (int e = 0; e < 4; ++e) { const float a = fmaxf(v0[e], 0.f), b = fmaxf(v1[e], 0.f); v0[e] = a * a; v1[e] = b * b; } }
                    u32x4 w; w.x = pk_f16(v0[0], v0[1]); w.y = pk_f16(v0[2], v0[3]); w.z = pk_f16(v1[0], v1[1]); w.w = pk_f16(v1[2], v1[3]);
                    *(u32x4*)(rowp + bj * HALF) = w; } }
    }
};
struct EpiIn {
    static constexpr bool PERM = true, AFTER_DRAIN = false;
    bf16_t* O; int ldc; const float* bias; float* RAW; int rawt;
    __device__ __forceinline__ void operator()(const f32x4 (&acc)[2][2][4][2], const Unit& u, int wr, int wc, int fr, int fq) const {
        const int row0 = u.pm * BM + wr * 64 + fr; const int col0 = u.pn * BM + wc * 32 + 8 * fq;
        f32x4 bv[2][2];
#pragma unroll
        for (int bj = 0; bj < 2; ++bj)
#pragma unroll
            for (int n = 0; n < 2; ++n) bv[bj][n] = *(const f32x4*)(bias + col0 + bj * HALF + 4 * n);
        const bool raw = (u.pn == rawt);
#pragma unroll
        for (int ai = 0; ai < 2; ++ai)
#pragma unroll
            for (int m = 0; m < 4; ++m) { const size_t row = (size_t)(row0 + ai * HALF + m * 16); bf16_t* rowp = O + row * ldc + col0; float* rawp = RAW + row * 256 + wc * 32 + 8 * fq;
#pragma unroll
                for (int bj = 0; bj < 2; ++bj) { const f32x4 v0 = acc[ai][bj][m][0] + bv[bj][0], v1 = acc[ai][bj][m][1] + bv[bj][1];
                    if (raw) { *(f32x4*)(rawp + bj * HALF) = v0; *(f32x4*)(rawp + bj * HALF + 4) = v1; }
                    else { u32x4 w; w.x = pk_f16(v0[0], v0[1]); w.y = pk_f16(v0[2], v0[3]); w.z = pk_f16(v1[0], v1[1]); w.w = pk_f16(v1[2], v1[3]);
                        *(u32x4*)(rowp + bj * HALF) = w; } } }
    }
};
struct EpiKV {
    static constexpr bool PERM = true, AFTER_DRAIN = false;
    bf16_t* KM; bf16_t* VT; const float* bias;
    __device__ __forceinline__ void operator()(const f32x4 (&acc)[2][2][4][2], const Unit& u, int wr, int wc, int fr, int fq) const {
        const int col0 = u.pn * BM + wc * 32 + 8 * fq;
        f32x4 bv[2][2];
#pragma unroll
        for (int bj = 0; bj < 2; ++bj)
#pragma unroll
            for (int n = 0; n < 2; ++n) bv[bj][n] = *(const f32x4*)(bias + col0 + bj * HALF + 4 * n);
        const bool isv = u.pn >= 4;
#pragma unroll
        for (int ai = 0; ai < 2; ++ai)
#pragma unroll
            for (int m = 0; m < 4; ++m) { const int j = wr * 64 + fr + ai * HALF + m * 16;
#pragma unroll
                for (int bj = 0; bj < 2; ++bj) { const f32x4 v0 = acc[ai][bj][m][0] + bv[bj][0], v1 = acc[ai][bj][m][1] + bv[bj][1];
                    if (!isv) { u32x4 w; w.x = pk_f16(v0[0], v0[1]); w.y = pk_f16(v0[2], v0[3]); w.z = pk_f16(v1[0], v1[1]); w.w = pk_f16(v1[2], v1[3]);
                        *(u32x4*)(KM + (size_t)(u.pm * BM + j) * 1024 + col0 + bj * HALF) = w; }
                    else { _Float16* vt = (_Float16*)VT + ((size_t)(u.pm * 4 + (u.pn - 4)) * 256 + (wc * 32 + 8 * fq + bj * HALF)) * 256 + j;
#pragma unroll
                        for (int e = 0; e < 4; ++e) { vt[(size_t)e * 256] = (_Float16)v0[e]; vt[(size_t)(4 + e) * 256] = (_Float16)v1[e]; } } } }
    }
};
struct EpiPre {
    static constexpr bool PERM = false, AFTER_DRAIN = false;
    const bf16_t* base; float* out; int ldc; const float* bias; float alpha;
    __device__ __forceinline__ void operator()(const f32x4 (&acc)[2][2][4][2], const Unit& u, int wr, int wc, int fr, int fq) const {
        const int col0 = u.pn * BM + wc * 32 + 4 * fq;
        f32x4 bv[2][2];
#pragma unroll
        for (int bj = 0; bj < 2; ++bj)
#pragma unroll
            for (int n = 0; n < 2; ++n) bv[bj][n] = *(const f32x4*)(bias + col0 + bj * HALF + n * 16);
#pragma unroll
        for (int ai = 0; ai < 2; ++ai)
#pragma unroll
            for (int m = 0; m < 4; ++m) { const size_t off = (size_t)(u.pm * BM + ai * HALF + wr * 64 + m * 16 + fr) * ldc + col0;
#pragma unroll
                for (int bj = 0; bj < 2; ++bj)
#pragma unroll
                    for (int n = 0; n < 2; ++n) { const f16x4 bs = *(const f16x4*)(base + off + bj * HALF + n * 16);
                        f32x4 v = acc[ai][bj][m][n] + bv[bj][n];
#pragma unroll
                        for (int e = 0; e < 4; ++e) v[e] += alpha * (float)bs[e];
                        *(f32x4*)(out + off + bj * HALF + n * 16) = v; } }
    }
};

template <class Epi, class Sched, bool ALIGN_EPI = false, bool SP2 = false>
__device__ __forceinline__ void gemm_phase(PG8_LAS unsigned char* lds, const Gemm g, const Sched& S, const Epi& E) {
    int tid_ = threadIdx.x; asm volatile("" : "+v"(tid_));
    const int tid = tid_, wid = __builtin_amdgcn_readfirstlane(tid >> 6), lane = tid & 63, wr = wid >> 2, wc = wid & 3, fr = lane & 15, fq = lane >> 4;
    const int K = g.K, nt = K / BK;
    unsigned voffA[2], voffB[2];
#pragma unroll
    for (int i = 0; i < 2; ++i) { int R, C; stage_rc(tid * 16 + i * 8192, R, C); const int Rb = Epi::PERM ? ((R & ~31) + perm32(R & 31)) : R;
        voffA[i] = (unsigned)(R * K + C) * 2u; voffB[i] = (unsigned)(Rb * K + C) * 2u; }
    const size_t kstep = (size_t)(BK * 2);
    const size_t hstep = (size_t)HALF * K * 2;
    const size_t tstep = 2 * hstep;
    const unsigned ldsw = (unsigned)wid * 1024u;
    const int aoff = lds_byte(wr * 64 + fr, fq * 8), boff = lds_byte(wc * 32 + fr, fq * 8);
#define PG8_SA(b, h) (((b) * 2 + (h)) * HTB)
#define PG8_SB(b, h) ((4 + (b) * 2 + (h)) * HTB)
#define PG8_STAGE(bufoff, gbase, voff) do { _Pragma("unroll") for (int _i = 0; _i < 2; ++_i) \
        __builtin_amdgcn_global_load_lds((const unsigned*)((const char*)(gbase) + (voff)[_i]), (PG8_LAS unsigned*)(lds + (bufoff) + ldsw + _i * 8192), 16, 0, 0); } while (0)
#define PG8_LDA(dst, b, h) do { _Pragma("unroll") for (int m = 0; m < 4; ++m) _Pragma("unroll") for (int k = 0; k < 2; ++k) dst[m][k] = *(const PG8_LAS bf16x8*)(lds + PG8_SA(b, h) + aoff + m * 2048 + k * 1024); } while (0)
#define PG8_LDB(dst, b, h) do { _Pragma("unroll") for (int n = 0; n < 2; ++n) _Pragma("unroll") for (int k = 0; k < 2; ++k) dst[n][k] = *(const PG8_LAS bf16x8*)(lds + PG8_SB(b, h) + boff + n * 2048 + k * 1024); } while (0)
#define PG8_MMA(ai, bj, At, Bt) do { __builtin_amdgcn_s_setprio(1); _Pragma("unroll") for (int m = 0; m < 4; ++m) _Pragma("unroll") for (int n = 0; n < 2; ++n) _Pragma("unroll") for (int k = 0; k < 2; ++k) \
        acc[ai][bj][m][n] = __builtin_amdgcn_mfma_f32_16x16x32_f16(Bt[n][k], At[m][k], acc[ai][bj][m][n], 0, 0, 0); __builtin_amdgcn_s_setprio(0); } while (0)
#define PG8_WAIT_V(n) asm volatile("s_waitcnt vmcnt(" #n ")" ::: "memory")
#define PG8_WAIT_L(n) asm volatile("s_waitcnt lgkmcnt(" #n ")" ::: "memory")
#define PG8_BAR __builtin_amdgcn_s_barrier()
#define PG8_SCHED __builtin_amdgcn_sched_barrier(0)
    Unit cur, nxt; int ui = 0;
    if (!S.next(0, cur)) return;
    f32x4 acc[2][2][4][2];
#pragma unroll
    for (int a = 0; a < 2; ++a)
#pragma unroll
        for (int b = 0; b < 2; ++b)
#pragma unroll
            for (int m = 0; m < 4; ++m)
#pragma unroll
                for (int n = 0; n < 2; ++n) acc[a][b][m][n] = (f32x4){0.f, 0.f, 0.f, 0.f};
    bf16x8 At[4][2], B0[2][2], B1[2][2];
    const char* cA = (const char*)g.A + (size_t)cur.pm * tstep; const char* cB = (const char*)g.Bt + (size_t)cur.pn * tstep;
    S.a_ready(cur);
    if constexpr (SP2) {
        PG8_STAGE(PG8_SB(0, 0), cB, voffB); PG8_STAGE(PG8_SB(0, 1), cB + hstep, voffB); PG8_STAGE(PG8_SA(0, 0), cA, voffA); PG8_STAGE(PG8_SA(0, 1), cA + hstep, voffA);
        if (wr == 1) PG8_BAR;
        PG8_WAIT_V(2); PG8_BAR;
        PG8_STAGE(PG8_SB(1, 0), cB + kstep, voffB); PG8_STAGE(PG8_SA(1, 0), cA + kstep, voffA); PG8_STAGE(PG8_SB(1, 1), cB + hstep + kstep, voffB);
        PG8_WAIT_V(6); PG8_BAR;
    } else {
        PG8_STAGE(PG8_SB(0, 0), cB, voffB); PG8_STAGE(PG8_SA(0, 0), cA, voffA); PG8_STAGE(PG8_SB(0, 1), cB + hstep, voffB); PG8_STAGE(PG8_SA(0, 1), cA + hstep, voffA);
        if (wr == 1) PG8_BAR;
        PG8_WAIT_V(4); PG8_BAR;
        PG8_STAGE(PG8_SB(1, 0), cB + kstep, voffB); PG8_STAGE(PG8_SA(1, 0), cA + kstep, voffA); PG8_STAGE(PG8_SB(1, 1), cB + hstep + kstep, voffB);
        PG8_WAIT_V(6); PG8_BAR;
    }
    for (;;) {
        const bool has_next = S.next(ui + 1, nxt);
        const char* nA = has_next ? (const char*)g.A + (size_t)nxt.pm * tstep : cA; const char* nB = has_next ? (const char*)g.Bt + (size_t)nxt.pn * tstep : cB;
        for (int t = 0; t < nt; t += 2) {
            const bool last = (t == nt - 2);
            const char* a1 = cA + (size_t)(t + 1) * kstep;
            const char* a2 = last ? nA : cA + (size_t)(t + 2) * kstep; const char* b2 = last ? nB : cB + (size_t)(t + 2) * kstep;
            const char* a3 = a2 + kstep; const char* b3 = b2 + kstep;
            if (last && has_next) S.a_ready(nxt);
            if constexpr (SP2) {
            PG8_LDB(B0, 0, 0); PG8_LDB(B1, 0, 1); PG8_SCHED; PG8_LDA(At, 0, 0); PG8_STAGE(PG8_SA(1, 1), a1 + hstep, voffA);
            PG8_WAIT_V(8); PG8_WAIT_L(0); PG8_BAR; PG8_MMA(0, 0, At, B0); PG8_MMA(0, 1, At, B1); PG8_BAR; PG8_SCHED;
            PG8_LDA(At, 0, 1); PG8_STAGE(PG8_SB(0, 0), b2, voffB); PG8_STAGE(PG8_SB(0, 1), b2 + hstep, voffB); PG8_STAGE(PG8_SA(0, 0), a2, voffA);
            PG8_WAIT_V(8); PG8_WAIT_L(0); PG8_BAR; PG8_MMA(1, 0, At, B0); PG8_MMA(1, 1, At, B1); PG8_BAR; PG8_SCHED;
            PG8_LDB(B0, 1, 0); PG8_LDB(B1, 1, 1); PG8_SCHED; PG8_LDA(At, 1, 0); PG8_STAGE(PG8_SA(0, 1), a2 + hstep, voffA);
            PG8_WAIT_V(8); PG8_WAIT_L(0); PG8_BAR; PG8_MMA(0, 0, At, B0); PG8_MMA(0, 1, At, B1); PG8_BAR; PG8_SCHED;
            PG8_LDA(At, 1, 1); PG8_STAGE(PG8_SB(1, 0), b3, voffB); PG8_STAGE(PG8_SB(1, 1), b3 + hstep, voffB); PG8_STAGE(PG8_SA(1, 0), a3, voffA);
            PG8_WAIT_V(8); PG8_WAIT_L(0); PG8_BAR; PG8_MMA(1, 0, At, B0); PG8_MMA(1, 1, At, B1); PG8_BAR; PG8_SCHED;
            } else {
            PG8_LDB(B0, 0, 0); PG8_SCHED; PG8_LDA(At, 0, 0); PG8_STAGE(PG8_SA(1, 1), a1 + hstep, voffA);
            PG8_WAIT_L(8); PG8_BAR; PG8_WAIT_L(0); PG8_MMA(0, 0, At, B0); PG8_BAR; PG8_SCHED;
            PG8_LDB(B1, 0, 1); PG8_STAGE(PG8_SB(0, 0), b2, voffB);
            PG8_BAR; PG8_WAIT_L(0); PG8_MMA(0, 1, At, B1); PG8_BAR;
            PG8_LDA(At, 0, 1); PG8_STAGE(PG8_SA(0, 0), a2, voffA);
            PG8_BAR; PG8_WAIT_L(0); PG8_MMA(1, 0, At, B0); PG8_BAR; PG8_SCHED;
            PG8_STAGE(PG8_SB(0, 1), b2 + hstep, voffB);
            PG8_WAIT_V(6); PG8_BAR; PG8_MMA(1, 1, At, B1); PG8_BAR;
            PG8_LDB(B0, 1, 0); PG8_SCHED; PG8_LDA(At, 1, 0); PG8_STAGE(PG8_SA(0, 1), a2 + hstep, voffA);
            PG8_WAIT_L(8); PG8_BAR; PG8_WAIT_L(0); PG8_MMA(0, 0, At, B0); PG8_BAR; PG8_SCHED;
            PG8_LDB(B1, 1, 1); PG8_STAGE(PG8_SB(1, 0), b3, voffB);
            PG8_BAR; PG8_WAIT_L(0); PG8_MMA(0, 1, At, B1); PG8_BAR;
            PG8_LDA(At, 1, 1); PG8_STAGE(PG8_SA(1, 0), a3, voffA);
            PG8_BAR; PG8_WAIT_L(0); PG8_MMA(1, 0, At, B0); PG8_BAR; PG8_SCHED;
            PG8_STAGE(PG8_SB(1, 1), b3 + hstep, voffB);
            PG8_WAIT_V(6); PG8_BAR; PG8_MMA(1, 1, At, B1); PG8_BAR;
            }
        }
        if constexpr (ALIGN_EPI) { if (wr == 0) PG8_BAR; }
        if constexpr (!Epi::AFTER_DRAIN) { E(acc, cur, wr, wc, fr, fq); S.done(cur); }
        if (!has_next) break;
#pragma unroll
        for (int a = 0; a < 2; ++a)
#pragma unroll
            for (int b = 0; b < 2; ++b)
#pragma unroll
                for (int m = 0; m < 4; ++m)
#pragma unroll
                    for (int n = 0; n < 2; ++n) acc[a][b][m][n] = (f32x4){0.f, 0.f, 0.f, 0.f};
        cur = nxt; cA = nA; cB = nB; ++ui;
        if constexpr (ALIGN_EPI) { if (wr == 1) PG8_BAR; }
    }
    PG8_WAIT_V(0);
    if constexpr (!ALIGN_EPI) { if (wr == 0) PG8_BAR; }
    PG8_BAR;
    if constexpr (Epi::AFTER_DRAIN) { E.fused(acc, cur, wr, wc, fr, fq, lds, wid, lane); S.done(cur); }
#undef PG8_SA
#undef PG8_SB
#undef PG8_STAGE
#undef PG8_LDA
#undef PG8_LDB
#undef PG8_MMA
#undef PG8_WAIT_V
#undef PG8_WAIT_L
#undef PG8_BAR
#undef PG8_SCHED
}

}

constexpr int NB = 8, T = 4096, M = NB * T, D = 1024, DIN = 1992, NIN = 2560, MIXK = 1536, FF = 4096, MEML = 256, MROWS = NB * MEML;
constexpr int RAWT = 7;
constexpr float LN_EPS = 1e-5f, DN_ALPHA = 1.189207115002721f;
constexpr float NEG_INF = -1e30f;
constexpr size_t MiB = 1u << 20;
constexpr size_t WS_CTL = 0, CTL_BYTES = 1 * MiB;
constexpr size_t WS_RELB = 1 * MiB;
constexpr size_t WS_BINP = 1 * MiB + 65536;
constexpr size_t WS_BT_IN = 2 * MiB, WS_BT_O = 7 * MiB, WS_BT_Q = 10 * MiB, WS_BT_KV = 12 * MiB, WS_BT_WO = 16 * MiB, WS_BT_UP = 18 * MiB, WS_BT_DN = 26 * MiB;
constexpr size_t WS_MEM16 = 34 * MiB, WS_KVM = 38 * MiB;
constexpr size_t WS_X16 = 48 * MiB, WS_MIX = 112 * MiB, WS_H = 208 * MiB, WS_RAW = 368 * MiB, WS_SCR = 368 * MiB, WS_CB = 496 * MiB, WS_IK = 504 * MiB, WS_IW = 508 * MiB;
constexpr size_t WS_Q2 = 208 * MiB, WS_O2 = 272 * MiB, WS_HFF = 208 * MiB, WS_END = 510 * MiB;

typedef unsigned short h16;
typedef _Float16 f16;
typedef _Float16 f16x2 __attribute__((ext_vector_type(2)));
typedef _Float16 f16x4 __attribute__((ext_vector_type(4)));
typedef _Float16 f16x8 __attribute__((ext_vector_type(8)));
typedef float f32x4 __attribute__((ext_vector_type(4)));
typedef float f32x2 __attribute__((ext_vector_type(2)));
typedef unsigned u32x4 __attribute__((ext_vector_type(4)));
typedef unsigned u32x2 __attribute__((ext_vector_type(2)));
#define LAS __attribute__((address_space(3)))
typedef float f32x16 __attribute__((ext_vector_type(16)));
typedef short v4i16 __attribute__((ext_vector_type(4)));
typedef short v8i16 __attribute__((ext_vector_type(8)));
typedef unsigned short u16x8 __attribute__((ext_vector_type(8)));
__device__ __forceinline__ unsigned off_b(unsigned row, unsigned ch) { return 256u * row + 16u * (ch ^ (((row & 3) << 2) | ((row >> 2) & 3))); }
__device__ __forceinline__ unsigned tr_addr16(unsigned lane, unsigned c, unsigned t) { const unsigned g = lane >> 4, q = (lane & 15) >> 2, p = lane & 3; return off_b(8 * g + 4 * t + q, 2 * c + (p >> 1)) + 8 * (p & 1); }

__device__ const unsigned char REL_BUCKET[129] = {0, 1, 2, 3, 4, 5, 6, 7, 8, 9, 10, 11, 12, 13, 14, 15, 16, 16, 16, 17, 17, 18, 18, 18, 19, 19, 19, 20, 20, 20, 20, 21, 21, 21, 21, 22, 22, 22, 22, 22, 23, 23, 23, 23, 23, 23, 24, 24, 24, 24, 24, 24, 25, 25, 25, 25, 25, 25, 25, 26, 26, 26, 26, 26, 26, 26, 26, 27, 27, 27, 27, 27, 27, 27, 27, 27, 27, 28, 28, 28, 28, 28, 28, 28, 28, 28, 28, 29, 29, 29, 29, 29, 29, 29, 29, 29, 29, 29, 29, 30, 30, 30, 30, 30, 30, 30, 30, 30, 30, 30, 30, 30, 30, 31, 31, 31, 31, 31, 31, 31, 31, 31, 31, 31, 31, 31, 31, 31, 31};

struct Params { const float* in[31]; float* out; unsigned char* ws; };
enum { I_X = 0, I_MEM, I_LNE_G, I_LNE_B, I_W_IN, I_B_IN, I_SINKS, I_KVN_G, I_W_UK, I_W_UV, I_IKLN_G, I_IKLN_B, I_REL, I_W_O, I_B_O, I_LN1_G, I_LN1_B, I_WQ, I_BQ, I_WKV, I_BKV, I_WO, I_BO,
       I_LN2_G, I_LN2_B, I_W_UP, I_B_UP, I_W_DN, I_B_DN, I_LN3_G, I_LN3_B };

__device__ __forceinline__ float wave_sum(float v) {
#pragma unroll
    for (int o = 1; o < 64; o <<= 1) v += __shfl_xor(v, o);
    return v;
}
__device__ __forceinline__ float wave_max(float v) {
#pragma unroll
    for (int o = 1; o < 64; o <<= 1) v = fmaxf(v, __shfl_xor(v, o));
    return v;
}
__device__ __forceinline__ int wave_sum_i(int v) {
#pragma unroll
    for (int o = 1; o < 64; o <<= 1) v += __shfl_xor(v, o);
    return v;
}
__device__ __forceinline__ unsigned pk2h(float lo, float hi) { return pg8::pk_f16(lo, hi); }
__device__ __forceinline__ float ld_sc1(const float* p) { return __hip_atomic_load(p, __ATOMIC_RELAXED, __HIP_MEMORY_SCOPE_AGENT); }

__device__ __forceinline__ void p0_transpose_item(const float* W, int ldw, int col0, h16* WT, int ldd, int row0, int nblk, LAS float* scr, int item, int lane) {
    const int kb = item / nblk, nb = item % nblk, k0 = 64 * kb, n0 = 32 * nb;
#pragma unroll 8
    for (int i = 0; i < 32; ++i) { const int kk = 2 * i + (lane >> 5); scr[kk * 33 + (lane & 31)] = W[(size_t)(k0 + kk) * ldw + col0 + n0 + (lane & 31)]; }
    asm volatile("s_waitcnt lgkmcnt(0)" ::: "memory");
    const int c = lane & 7;
#pragma unroll
    for (int j = 0; j < 4; ++j) { const int n = (lane >> 3) + 8 * j; const LAS float* s = scr + (8 * c) * 33 + n;
        u32x4 o; o.x = pk2h(s[0 * 33], s[1 * 33]); o.y = pk2h(s[2 * 33], s[3 * 33]); o.z = pk2h(s[4 * 33], s[5 * 33]); o.w = pk2h(s[6 * 33], s[7 * 33]);
        *(u32x4*)(WT + (size_t)(row0 + n0 + n) * ldd + k0 + 8 * c) = o; }
    asm volatile("s_waitcnt lgkmcnt(0)" ::: "memory");
}

template <bool OUT16> __device__ __forceinline__ void ln_row(const float* xrow, const float* g, const float* b, void* orow, int lane) {
    const f32x4* xr = (const f32x4*)xrow + lane;
    f32x4 v[4]; float s = 0.f;
#pragma unroll
    for (int j = 0; j < 4; ++j) { v[j] = xr[64 * j]; s += (v[j].x + v[j].y) + (v[j].z + v[j].w); }
    const float mean = wave_sum(s) * (1.f / D); float s2 = 0.f;
#pragma unroll
    for (int j = 0; j < 4; ++j) { v[j] = v[j] - mean; s2 += (v[j].x * v[j].x + v[j].y * v[j].y) + (v[j].z * v[j].z + v[j].w * v[j].w); }
    const float rstd = 1.f / sqrtf(wave_sum(s2) * (1.f / D) + LN_EPS);
#pragma unroll
    for (int j = 0; j < 4; ++j) { const f32x4 gg = ((const f32x4*)g)[lane + 64 * j], bb = ((const f32x4*)b)[lane + 64 * j]; const f32x4 o = v[j] * rstd * gg + bb;
        if (OUT16) { u32x2 w; w.x = pk2h(o.x, o.y); w.y = pk2h(o.z, o.w); ((u32x2*)orow)[lane + 64 * j] = w; }
        else ((f32x4*)orow)[lane + 64 * j] = o; }
}

__device__ __forceinline__ unsigned mono_key(float f) { unsigned b = __float_as_uint(f); if (b == 0x80000000u) b = 0u; return b ^ ((unsigned)((int)b >> 31) | 0x80000000u); }
__device__ __forceinline__ int wave_sum_dpp(int c) {
    int x = c;
    x += __builtin_amdgcn_update_dpp(0, x, 0x111, 0xf, 0xf, false);
    x += __builtin_amdgcn_update_dpp(0, x, 0x112, 0xf, 0xf, false);
    x += __builtin_amdgcn_update_dpp(0, x, 0x114, 0xf, 0xf, false);
    x += __builtin_amdgcn_update_dpp(0, x, 0x118, 0xf, 0xf, false);
    x += __builtin_amdgcn_update_dpp(0, x, 0x142, 0xa, 0xf, false);
    x += __builtin_amdgcn_update_dpp(0, x, 0x143, 0xc, 0xf, false);
    return __builtin_amdgcn_readlane(x, 63);
}
__device__ __forceinline__ int count_ge(const unsigned (&u)[64], unsigned cand, int ngrp) {
    int c = 0;
#pragma unroll
    for (int gq = 0; gq < 4; ++gq) if (gq < ngrp) {
#pragma unroll
        for (int jj = 0; jj < 16; ++jj) c += (u[gq * 16 + jj] >= cand) ? 1 : 0; }
    return wave_sum_dpp(c);
}
__device__ __forceinline__ int select_topk(const unsigned (&u)[64], int n, int ngrp, LAS unsigned short* idx, int lane) {
    unsigned th = 0u; int need = 0;
    if (n > 256) {
        unsigned lo = 0u; bool exact = false;
        for (int bit = 31; bit >= 0; --bit) {
            const unsigned cand = lo | (1u << bit); const int c = count_ge(u, cand, ngrp);
            if (c == 256) { th = cand - 1u; need = 0; exact = true; break; }
            if (c > 256) lo = cand;
        }
        if (!exact) { th = lo; need = 256 - count_ge(u, lo + 1u, ngrp); }
    }
    int base = 0, tie_seen = 0;
    const unsigned long long lt = (1ull << lane) - 1ull;
#pragma unroll
    for (int gq = 0; gq < 4; ++gq) if (gq < ngrp) {
#pragma unroll
        for (int jj = 0; jj < 16; ++jj) {
            const int j = gq * 16 + jj;
            const bool gt = u[j] > th; const bool eq = (need > 0) && (u[j] == th);
            const unsigned long long meq = __ballot(eq);
            const int eq_rank = tie_seen + __popcll(meq & lt);
            const bool sel = gt || (eq && eq_rank < need);
            const unsigned long long msel = __ballot(sel);
            const int pos = base + __popcll(msel & lt);
            if (sel) idx[pos] = (unsigned short)(64 * j + lane);
            base += __popcll(msel); tie_seen += __popcll(meq);
        } }
    return base;
}

#define XB_TMO      128
#define XB_XCNT(j)  (256  + 64 * (j))
#define XB_XSUB(j)  (1280 + 64 * (j))
#define XB_XGEN(j)  (2304 + 64 * (j))
#define XB_TOP      3328
#define XB_TOPGEN   3392
#define XCD_BAR_WORDS 3456
#define XB_SPIN_CAP (1u << 18)

__device__ __forceinline__ unsigned xb_ld(unsigned* p)              { return __hip_atomic_load(p, __ATOMIC_RELAXED, __HIP_MEMORY_SCOPE_AGENT); }
__device__ __forceinline__ unsigned xb_add(unsigned* p, unsigned v) { return __hip_atomic_fetch_add(p, v, __ATOMIC_RELAXED, __HIP_MEMORY_SCOPE_AGENT); }
__device__ __forceinline__ unsigned xb_xcc_id() { return (unsigned)__builtin_amdgcn_s_getreg((3 << 11) | 20) & 0xFu; }
#define XB_SPIN(cond, bar) do { unsigned _sp = 0; while (cond) { __builtin_amdgcn_s_sleep(1); \
    if ((++_sp & 255u) == 0u) { if (xb_ld(&(bar)[XB_TMO])) break; if (_sp > XB_SPIN_CAP) { atomicAdd(&(bar)[XB_TMO], 1u); break; } } } } while (0)

struct XcdBarrier {
    unsigned* bar; unsigned x;
    volatile LAS unsigned* st;
};

__device__ __forceinline__ XcdBarrier xcd_barrier_post(unsigned* bar, volatile LAS unsigned* st) {
    XcdBarrier b; b.bar = bar; b.x = xb_xcc_id(); b.st = st;
    if (threadIdx.x == 0) (void)xb_add(&bar[XB_XCNT(b.x)], 1u);
    return b;
}
__device__ __forceinline__ void xcd_barrier_complete(unsigned* bar, unsigned x, unsigned& nloc, unsigned& nx) {
    const unsigned G = gridDim.x * gridDim.y * gridDim.z;
    unsigned sum, cnt, mine, sp = 0u;
    for (;;) {
        sum = 0u; cnt = 0u; mine = 0u;
#pragma unroll
        for (unsigned j = 0; j < 16; ++j) { const unsigned c = xb_ld(&bar[XB_XCNT(j)]); sum += c; cnt += (c > 0u) ? 1u : 0u; mine = (j == x) ? c : mine; }
        if (sum == G) break;
        __builtin_amdgcn_s_sleep(1);
        if ((++sp & 255u) == 0u) { if (xb_ld(&bar[XB_TMO])) break; if (sp > XB_SPIN_CAP) { atomicAdd(&bar[XB_TMO], 1u); break; } }
    }
    nloc = mine > 0u ? mine : 1u; nx = cnt > 0u ? cnt : 1u;
}

__device__ __forceinline__ void xcd_barrier(const XcdBarrier& b) {
    asm volatile("s_waitcnt vmcnt(0)" ::: "memory");
    __syncthreads();
    if (threadIdx.x == 0) {
        unsigned* bar = b.bar;
        __builtin_amdgcn_s_waitcnt(0);
        unsigned nloc = b.st[0], nx = b.st[1];
        if (nloc == 0u) { xcd_barrier_complete(bar, b.x, nloc, nx); b.st[0] = nloc; b.st[1] = nx; }
        const unsigned old = xb_add(&bar[XB_XSUB(b.x)], 1u);
        const unsigned gen = old / nloc;
        if (old + 1u == (gen + 1u) * nloc) {
            __builtin_amdgcn_fence(__ATOMIC_RELEASE, "agent");
            asm volatile("s_waitcnt vmcnt(0)" ::: "memory");
            const unsigned og = xb_add(&bar[XB_TOP], 1u);
            const unsigned tg = og / nx;
            if (og + 1u == (tg + 1u) * nx) xb_add(&bar[XB_TOPGEN], 1u);
            else XB_SPIN(xb_ld(&bar[XB_TOPGEN]) == tg, bar);
            __builtin_amdgcn_fence(__ATOMIC_ACQUIRE, "agent");
            xb_add(&bar[XB_XGEN(b.x)], 1u);
            asm volatile("s_waitcnt vmcnt(0)" ::: "memory");
        } else {
            XB_SPIN(xb_ld(&bar[XB_XGEN(b.x)]) == gen, bar);
            __builtin_amdgcn_fence(__ATOMIC_ACQUIRE, "agent");
            asm volatile("s_waitcnt vmcnt(0)" ::: "memory");
        }
    }
    __syncthreads();
}

#ifndef PHM
#define PHM 0xFFFF
#endif
constexpr int NWAVES = 8, NTHREADS = 512;
constexpr int LDS_BYTES = 147456;

__global__ void __launch_bounds__(NTHREADS, 2) fwd_kernel(Params p) {
    extern __shared__ __attribute__((aligned(16))) unsigned char lds_raw[];
    LAS unsigned char* lds = (LAS unsigned char*)lds_raw;
    int tid = threadIdx.x, lane = tid & 63; const int wave = __builtin_amdgcn_readfirstlane(tid >> 6);
    volatile LAS unsigned* MISC = (volatile LAS unsigned*)(lds + LDS_BYTES - 256);
    if (tid < 64) MISC[tid] = 0u;
    __syncthreads();
    const XcdBarrier xbar = xcd_barrier_post((unsigned*)(p.ws + WS_CTL) + 4096, MISC + 8);
#define GSYNC() do { xcd_barrier(xbar); asm volatile("" : "+v"(lane), "+v"(tid)); } while (0)
    const int G = gridDim.x, gw = blockIdx.x * NWAVES + wave, NGW = G * NWAVES;
    unsigned char* ws = p.ws;
    float* RELB = (float*)(ws + WS_RELB); float* BINP = (float*)(ws + WS_BINP);
    h16* BT_IN = (h16*)(ws + WS_BT_IN); h16* BT_O = (h16*)(ws + WS_BT_O); h16* BT_Q = (h16*)(ws + WS_BT_Q); h16* BT_KV = (h16*)(ws + WS_BT_KV);
    h16* BT_WO = (h16*)(ws + WS_BT_WO); h16* BT_UP = (h16*)(ws + WS_BT_UP); h16* BT_DN = (h16*)(ws + WS_BT_DN);
    h16* MEM16 = (h16*)(ws + WS_MEM16); h16* KM = (h16*)(ws + WS_KVM); h16* VT = (h16*)(ws + WS_KVM + 4 * MiB); h16* X16 = (h16*)(ws + WS_X16); h16* MIX = (h16*)(ws + WS_MIX); h16* H = (h16*)(ws + WS_H);
    float* RAW = (float*)(ws + WS_RAW); h16* CB = (h16*)(ws + WS_CB); h16* IK16 = (h16*)(ws + WS_IK); float* IW = (float*)(ws + WS_IW); float* SCR = (float*)(ws + WS_SCR);
    h16* Q2 = (h16*)(ws + WS_Q2); h16* O2 = (h16*)(ws + WS_O2); h16* HFF = (h16*)(ws + WS_HFF);
    float* PRE = p.out;

    if (PHM & 1) {
        LAS float* scr = (LAS float*)(lds + wave * 16384);
        const float* W_IN = p.in[I_W_IN];
        constexpr int J0 = 16 * 16, J1 = 16 * 8, J2 = 16 * 4, J3 = 16 * 2, J4 = 16 * 16, J5 = 8 * 32, J6 = 16 * 32, J7 = 16 * 64, J8 = 16 * 32, J9 = 16 * 128, J10 = 64 * 32;
        constexpr int NIT = J0 + J1 + J2 + J3 + J4 + J5 + J6 + J7 + J8 + J9 + J10;
        for (int it = gw; it < NIT; it += NGW) {
            int r = it;
            if (r < J0) { p0_transpose_item(W_IN, DIN, 0, BT_IN, D, 0, 16, scr, r, lane); continue; } r -= J0;
            if (r < J1) { p0_transpose_item(W_IN, DIN, 512, BT_IN, D, 512, 8, scr, r, lane); continue; } r -= J1;
            if (r < J2) { p0_transpose_item(W_IN, DIN, 1280, BT_IN, D, 1792, 4, scr, r, lane); continue; } r -= J2;
            if (r < J3) { p0_transpose_item(W_IN, DIN, 1920, BT_IN, D, 1920, 2, scr, r, lane); continue; } r -= J3;
            if (r < J4) { p0_transpose_item(W_IN, DIN, 1408, BT_IN, D, 2048, 16, scr, r, lane); continue; } r -= J4;
            if (r < J5) { p0_transpose_item(p.in[I_W_O], D, 0, BT_O, MIXK, 0, 32, scr, r, lane); continue; } r -= J5;
            if (r < J6) { p0_transpose_item(p.in[I_WQ], D, 0, BT_Q, D, 0, 32, scr, r, lane); continue; } r -= J6;
            if (r < J7) { p0_transpose_item(p.in[I_WKV], 2 * D, 0, BT_KV, D, 0, 64, scr, r, lane); continue; } r -= J7;
            if (r < J8) { p0_transpose_item(p.in[I_WO], D, 0, BT_WO, D, 0, 32, scr, r, lane); continue; } r -= J8;
            if (r < J9) { p0_transpose_item(p.in[I_W_UP], FF, 0, BT_UP, D, 0, 128, scr, r, lane); continue; } r -= J9;
            p0_transpose_item(p.in[I_W_DN], D, 0, BT_DN, FF, 0, 32, scr, r, lane);
        }
        const float* WUK = p.in[I_W_UK]; const float* WUV = p.in[I_W_UV]; const float* W_O = p.in[I_W_O];
        for (int it = gw; it < 1024; it += NGW) {
            const int h = it >> 7, kt = (it >> 3) & 15, cs = it & 7, k = 64 * kt + lane;
            const f32x4* wr = (const f32x4*)(W_IN + (size_t)k * DIN + 768 + 64 * h);
            f32x4 w[16];
#pragma unroll
            for (int i = 0; i < 16; ++i) w[i] = wr[i];
#pragma unroll 1
            for (int ci = 0; ci < 16; ++ci) {
                const int n = h * 128 + 16 * cs + ci; const f32x4* ur = (const f32x4*)(WUK + (size_t)n * 64);
                float a = 0.f;
#pragma unroll
                for (int i = 0; i < 16; ++i) { const f32x4 uu = ur[i]; a += w[i].x * uu.x + w[i].y * uu.y + w[i].z * uu.z + w[i].w * uu.w; }
                ((f16*)BT_IN)[(size_t)(768 + n) * D + k] = (f16)(a * 0.125f);
            }
        }
        for (int it = gw; it < 1024; it += NGW) {
            const int h = it >> 7, nt = (it >> 3) & 15, cs = it & 7, n = 64 * nt + lane;
            float w[64];
#pragma unroll
            for (int d = 0; d < 64; ++d) w[d] = W_O[(size_t)(512 + 64 * h + d) * D + n];
#pragma unroll 1
            for (int ci = 0; ci < 16; ++ci) {
                const int j = h * 128 + 16 * cs + ci; const f32x4* vr = (const f32x4*)(WUV + (size_t)j * 64);
                float a = 0.f;
#pragma unroll
                for (int i = 0; i < 16; ++i) { const f32x4 vv = vr[i]; a += w[4 * i] * vv.x + w[4 * i + 1] * vv.y + w[4 * i + 2] * vv.z + w[4 * i + 3] * vv.w; }
                ((f16*)BT_O)[(size_t)n * MIXK + 512 + j] = (f16)a;
            }
        }
        for (int it = gw; it < 64 * 16; it += NGW) {
            const int r = it >> 4, k = ((it & 15) << 6) + lane;
            const float v = (r < 8) ? W_IN[(size_t)k * DIN + 1984 + r] : 0.f;
            ((f16*)BT_IN)[(size_t)(1984 + r) * D + k] = (f16)v;
        }
        const float* B_IN = p.in[I_B_IN];
        for (int n = gw * 64 + lane; n < NIN; n += NGW * 64) {
            float v;
            if (n < 768) v = B_IN[n];
            else if (n < 1792) { const int j = n - 768, h = j >> 7; float a = 0.f; for (int d = 0; d < 64; ++d) a += B_IN[768 + 64 * h + d] * WUK[(size_t)j * 64 + d]; v = a * 0.125f; }
            else if (n < 1920) v = B_IN[1280 + (n - 1792)];
            else if (n < 1992) v = B_IN[n];
            else if (n < 2048) v = 0.f;
            else v = B_IN[1408 + (n - 2048)];
            BINP[n] = v;
        }
        const float* REL = p.in[I_REL];
        for (int i = gw * 64 + lane; i < 16 * 132; i += NGW * 64) { const int h = i / 132, d = i % 132; RELB[i] = REL[(int)REL_BUCKET[d > 128 ? 128 : d] * 16 + h]; }
        const float* MEMF = p.in[I_MEM];
        for (int i = gw * 64 + lane; i < MROWS * D / 4; i += NGW * 64) { const f32x4 v = ((const f32x4*)MEMF)[i]; u32x2 w; w.x = pk2h(v.x, v.y); w.y = pk2h(v.z, v.w); ((u32x2*)MEM16)[i] = w; }
        for (int m = gw; m < M; m += NGW) ln_row<true>(p.in[I_X] + (size_t)m * D, p.in[I_LNE_G], p.in[I_LNE_B], X16 + (size_t)m * D, lane);
    }
    GSYNC();

    if (PHM & 2) {
        pg8::Gemm g{X16, BT_IN, M, NIN, D}; pg8::StaticOrder S; S.init(M, NIN, G, (int)blockIdx.x);
        pg8::EpiIn E{H, NIN, BINP, RAW, RAWT};
        pg8::gemm_phase<pg8::EpiIn, pg8::StaticOrder, true, true>(lds, g, S, E);
    }
    if (PHM & 4) {
        pg8::Gemm g{MEM16, BT_KV, MROWS, 2 * D, D}; pg8::StaticOrder S; S.init(MROWS, 2 * D, G, (int)blockIdx.x);
        pg8::EpiKV E{KM, VT, p.in[I_BKV]};
        pg8::gemm_phase<pg8::EpiKV, pg8::StaticOrder, true, true>(lds, g, S, E);
    }
    GSYNC();

    if (PHM & 8) {
        const float* KG = p.in[I_KVN_G]; const float* IG = p.in[I_IKLN_G]; const float* IB = p.in[I_IKLN_B];
        for (int m = gw; m < M; m += NGW) {
            const float* r = RAW + (size_t)m * 256;
            const float c0 = r[lane], c1 = r[64 + lane];
            const float rr = 1.f / sqrtf(wave_sum(c0 * c0 + c1 * c1) * (1.f / 128.f) + LN_EPS);
            ((f16*)CB)[(size_t)m * 128 + lane] = (f16)(c0 * rr * KG[lane]); ((f16*)CB)[(size_t)m * 128 + 64 + lane] = (f16)(c1 * rr * KG[64 + lane]);
            const float k = r[128 + lane]; const float mu = wave_sum(k) * (1.f / 64.f); const float dk = k - mu;
            const float rs = 1.f / sqrtf(wave_sum(dk * dk) * (1.f / 64.f) + LN_EPS);
            ((f16*)IK16)[(size_t)m * 64 + lane] = (f16)(dk * rs * IG[lane] + IB[lane]);
            if (lane < 8) IW[(size_t)m * 8 + lane] = r[192 + lane] * (0.35355339059327373f * 0.125f);
        }
    }
    GSYNC();

    if (PHM & 32) {
        LAS unsigned short* idx_all = (LAS unsigned short*)(lds + 65536);
        LAS float* relb_s = (LAS float*)(lds + 65536 + 16384);
        LAS int* s_item = (LAS int*)(lds + 65536 + 16384 + 4224);
        LAS float* rba_s = (LAS float*)(lds + 86400);
        for (int i = tid; i < 8 * 132; i += NTHREADS) relb_s[i] = RELB[8 * 132 + i];
        for (int i = tid; i < 8 * 128; i += NTHREADS) rba_s[i] = RELB[(i >> 7) * 132 + (i & 127)];
        float* SCRW = SCR + (size_t)blockIdx.x * (32 * 4096);
        unsigned* qctr = (unsigned*)(ws + WS_CTL) + 64;
        for (;;) {
            __syncthreads();
            if (tid == 0) *s_item = (int)atomicAdd(qctr, 1u);
            __syncthreads();
            const int item = *s_item;
            if (item >= NB * 128 + 512) break;
            if (item >= NB * 128) {
                const int unit = item - NB * 128, kvh = unit & 1, n = (unit >> 1) & 31, b = unit >> 6;
                LAS unsigned char* Ks = lds;
                LAS unsigned char* Vt = lds + 32768;
                asm volatile("" : "+v"(lane), "+v"(tid));
#pragma unroll
                for (int i = 0; i < 4; ++i) {
                    const int pz = tid + 512 * i, r = pz >> 3, ch = pz & 7;
                    u32x4 kv = (u32x4){0u, 0u, 0u, 0u}, vv = (u32x4){0u, 0u, 0u, 0u};
                    if (n > 0 || r >= 128) { const f16* src = (const f16*)H + (size_t)(b * T + 128 * (n - 1) + r) * NIN + 512 + kvh * 64 + 8 * ch; kv = *(const u32x4*)src; vv = *(const u32x4*)(src + 128); }
                    *(LAS u32x4*)(Ks + r * 128 + ((ch ^ ((r >> 1) & 7)) << 4)) = kv;
                    LAS unsigned short* vd = (LAS unsigned short*)(Vt + (8 * ch) * 520 + r * 2);
                    vd[0 * 260] = (unsigned short)(vv.x & 0xffffu); vd[1 * 260] = (unsigned short)(vv.x >> 16); vd[2 * 260] = (unsigned short)(vv.y & 0xffffu); vd[3 * 260] = (unsigned short)(vv.y >> 16);
                    vd[4 * 260] = (unsigned short)(vv.z & 0xffffu); vd[5 * 260] = (unsigned short)(vv.z >> 16); vd[6 * 260] = (unsigned short)(vv.w & 0xffffu); vd[7 * 260] = (unsigned short)(vv.w >> 16);
                }
                __syncthreads();
                const int c = lane & 31, hi = lane >> 5, hd = 4 * kvh + (wave & 3), qhalf = wave >> 2;
                const float sink = p.in[I_SINKS][hd];
                const LAS float* rbh = rba_s + hd * 128;
#pragma unroll 1
                for (int sb = 0; sb < 2; ++sb) {
                    const int j0 = 2 * qhalf + sb, q0 = 32 * j0;
                    const size_t mrow = (size_t)(b * T + 128 * n + q0 + c);
                    f16x8 qf[4];
#pragma unroll
                    for (int ks = 0; ks < 4; ++ks) qf[ks] = *(const f16x8*)((const f16*)H + mrow * NIN + hd * 64 + 16 * ks + 8 * hi);
                    f32x16 S[5];
#pragma unroll
                    for (int jt = 0; jt < 5; ++jt) {
#pragma unroll
                        for (int r = 0; r < 16; ++r) S[jt][r] = 0.f;
#pragma unroll
                        for (int ks = 0; ks < 4; ++ks) {
                            const f16x8 a = *(const LAS f16x8*)(Ks + (32 * (j0 + jt) + c) * 128 + (((2 * ks + hi) ^ ((c >> 1) & 7)) << 4));
                            S[jt] = __builtin_amdgcn_mfma_f32_32x32x16_f16(a, qf[ks], S[jt], 0, 0, 0);
                        }
                    }
                    float mx = sink;
#pragma unroll
                    for (int jt = 0; jt < 5; ++jt)
#pragma unroll
                        for (int r = 0; r < 16; ++r) {
                            const int si = 32 * (j0 + jt) + (r & 3) + 8 * (r >> 2) + 4 * hi; const int rel = q0 + c + 128 - si;
                            const bool valid = (rel >= 0) && (rel < 128) && (n > 0 || si >= 128);
                            const float l = valid ? S[jt][r] * 0.125f + rbh[rel & 127] : NEG_INF;
                            S[jt][r] = l; mx = fmaxf(mx, l);
                        }
                    mx = fmaxf(mx, __shfl_xor(mx, 32));
                    float sum = 0.f;
#pragma unroll
                    for (int jt = 0; jt < 5; ++jt)
#pragma unroll
                        for (int r = 0; r < 16; ++r) { const float e = __expf(S[jt][r] - mx); S[jt][r] = e; sum += e; }
                    sum += __shfl_xor(sum, 32);
                    const float inv = 1.f / (sum + __expf(sink - mx));
                    f32x16 o[2];
#pragma unroll
                    for (int dt = 0; dt < 2; ++dt)
#pragma unroll
                        for (int r = 0; r < 16; ++r) o[dt][r] = 0.f;
#pragma unroll
                    for (int jt = 0; jt < 5; ++jt)
#pragma unroll
                        for (int s = 0; s < 2; ++s) {
                            f16x8 pb;
#pragma unroll
                            for (int j = 0; j < 8; ++j) pb[j] = (f16)S[jt][8 * s + j];
#pragma unroll
                            for (int dt = 0; dt < 2; ++dt) {
                                const LAS unsigned char* vp = Vt + (32 * dt + c) * 520 + (32 * (j0 + jt) + 16 * s + 4 * hi) * 2;
                                const f16x4 v0 = *(const LAS f16x4*)vp, v1 = *(const LAS f16x4*)(vp + 16);
                                const f16x8 av = (f16x8){v0[0], v0[1], v0[2], v0[3], v1[0], v1[1], v1[2], v1[3]};
                                o[dt] = __builtin_amdgcn_mfma_f32_32x32x16_f16(av, pb, o[dt], 0, 0, 0);
                            }
                        }
                    f16* op = (f16*)MIX + mrow * MIXK + hd * 64 + 4 * hi;
#pragma unroll
                    for (int dt = 0; dt < 2; ++dt)
#pragma unroll
                        for (int rq = 0; rq < 4; ++rq) { u32x2 w; w.x = pk2h(o[dt][4 * rq] * inv, o[dt][4 * rq + 1] * inv); w.y = pk2h(o[dt][4 * rq + 2] * inv, o[dt][4 * rq + 3] * inv); *(u32x2*)(op + 32 * dt + 8 * rq) = w; }
                }
                continue;
            }
            const int qb32 = 127 - (item >> 3), b = item & 7;
            const int m0 = b * T + 32 * qb32;
            asm volatile("" : "+v"(lane));
            const int c32 = lane & 31, hi = lane >> 5;
            {
                f16x8 bq[8][4];
                const f16* iqp = (const f16*)H + (size_t)(m0 + c32) * NIN + 2048 + 8 * hi;
#pragma unroll
                for (int h = 0; h < 8; ++h)
#pragma unroll
                    for (int ks = 0; ks < 4; ++ks) bq[h][ks] = *(const f16x8*)(iqp + h * 64 + ks * 16);
                float iwv[8];
                { const f32x4 w0 = *(const f32x4*)(IW + (size_t)(m0 + c32) * 8), w1 = *(const f32x4*)(IW + (size_t)(m0 + c32) * 8 + 4);
                  iwv[0] = w0.x; iwv[1] = w0.y; iwv[2] = w0.z; iwv[3] = w0.w; iwv[4] = w1.x; iwv[5] = w1.y; iwv[6] = w1.z; iwv[7] = w1.w; }
                for (int kt = wave; kt <= qb32; kt += 8) {
                    const f16* ikp = (const f16*)IK16 + (size_t)(b * T + kt * 32 + c32) * 64 + 8 * hi;
                    f16x8 ak[4];
#pragma unroll
                    for (int ks = 0; ks < 4; ++ks) ak[ks] = *(const f16x8*)(ikp + ks * 16);
                    float sc[16];
#pragma unroll
                    for (int r = 0; r < 16; ++r) sc[r] = 0.f;
#pragma unroll
                    for (int h = 0; h < 8; ++h) {
                        f32x16 acc;
#pragma unroll
                        for (int r = 0; r < 16; ++r) acc[r] = 0.f;
#pragma unroll
                        for (int ks = 0; ks < 4; ++ks) acc = __builtin_amdgcn_mfma_f32_32x32x16_f16(ak[ks], bq[h][ks], acc, 0, 0, 0);
#pragma unroll
                        for (int r = 0; r < 16; ++r) { const int ai = __float_as_int(acc[r]); sc[r] += iwv[h] * __int_as_float(ai < 0 ? 0 : ai); }
#pragma unroll
                        for (int r = 0; r < 16; ++r) asm volatile("" : "+v"(sc[r]));
                    }
                    float* sp = SCRW + (size_t)c32 * 4096 + kt * 32 + 4 * hi;
#pragma unroll
                    for (int i = 0; i < 4; ++i) *(f32x4*)(sp + 8 * i) = (f32x4){sc[4 * i], sc[4 * i + 1], sc[4 * i + 2], sc[4 * i + 3]};
                }
            }
            asm volatile("s_waitcnt vmcnt(0)" ::: "memory");
            __syncthreads();
#pragma unroll 1
            for (int qi = 0; qi < 4; ++qi) {
                const int q = 4 * wave + qi, t = 32 * qb32 + q, m = m0 + q;
                int lane_o = lane; asm volatile("" : "+v"(lane_o));
                const int head = lane_o & 15, g = lane_o >> 4;
                LAS unsigned char* gb = lds + wave * 8192;
                LAS unsigned short* idxq = idx_all + q * 256;
                int cnt;
                {
                    unsigned u[64];
                    const float* sb = SCRW + (size_t)q * 4096 + lane; asm volatile("" : "+v"(sb));
                    const int ngrp = (t >> 10) + 1;
#pragma unroll
                    for (int gq = 0; gq < 4; ++gq) {
                        if (gq < ngrp) {
#pragma unroll
                            for (int jj = 0; jj < 16; ++jj) { const int j = gq * 16 + jj; u[j] = __float_as_uint(ld_sc1(sb + 64 * j)); }
                        } else {
#pragma unroll
                            for (int jj = 0; jj < 16; ++jj) u[gq * 16 + jj] = 0u;
                        }
                    }
#pragma unroll
                    for (int gq = 0; gq < 4; ++gq) {
                        if (gq < ngrp) {
#pragma unroll
                            for (int jj = 0; jj < 16; ++jj) { const int j = gq * 16 + jj; u[j] = (64 * j + lane <= t) ? mono_key(__uint_as_float(u[j])) : 0u; }
                        }
                    }
                    cnt = select_topk(u, t + 1, ngrp, idxq, lane);
                    for (int e = cnt + lane; e < 256; e += 64) idxq[e] = 0;
                }
                asm volatile("s_waitcnt lgkmcnt(0)" ::: "memory");
                {
                    f16x8 qf[4];
                    { const f16* qp = (const f16*)H + (size_t)m * NIN + 768 + (head & 7) * 128 + 8 * g;
#pragma unroll
                      for (int ks = 0; ks < 4; ++ks) { f16x8 v = *(const f16x8*)(qp + 32 * ks); if (head >= 8) v = (f16x8){0, 0, 0, 0, 0, 0, 0, 0}; qf[ks] = v; } }
                    const f16* cbb = (const f16*)CB + (size_t)(b * T) * 128 + (lane_o & 15) * 8;
                    u32x4 gr[2][8];
#pragma unroll
                    for (int hf = 0; hf < 2; ++hf)
#pragma unroll
                        for (int i = 0; i < 8; ++i) { const int s = (int)idxq[hf * 32 + 4 * i + g]; gr[hf][i] = *(const u32x4*)(cbb + (size_t)s * 128); }
                    float m_run = -3.0e38f, l_part = 0.f;
                    f32x4 o[8];
#pragma unroll
                    for (int ct = 0; ct < 8; ++ct) o[ct] = (f32x4){0.f, 0.f, 0.f, 0.f};
                    const int rowA0 = 8 * ((lane_o & 15) >> 2) + (lane_o & 3);
                    const LAS float* rbh = relb_s + (head & 7) * 132;
#pragma unroll 1
                    for (int cp = 0; cp < 4; ++cp) {
#pragma unroll
                      for (int hf = 0; hf < 2; ++hf) {
                        const int chunk = 2 * cp + hf;
#pragma unroll
                        for (int i = 0; i < 8; ++i) *(LAS u32x4*)(gb + off_b(4 * i + g, lane_o & 15)) = gr[hf][i];
                        if (cp < 3) {
#pragma unroll
                            for (int i = 0; i < 8; ++i) { const int s = (int)idxq[(chunk + 2) * 32 + 4 * i + g]; gr[hf][i] = *(const u32x4*)(cbb + (size_t)s * 128); }
                        }
                        f32x4 S0 = (f32x4){0.f, 0.f, 0.f, 0.f}, S1 = (f32x4){0.f, 0.f, 0.f, 0.f};
#pragma unroll
                        for (int ks = 0; ks < 4; ++ks) {
                            const f16x8 a0 = *(const LAS f16x8*)(gb + off_b(rowA0, 4 * ks + g)), a1 = *(const LAS f16x8*)(gb + off_b(rowA0 + 4, 4 * ks + g));
                            S0 = __builtin_amdgcn_mfma_f32_16x16x32_f16(a0, qf[ks], S0, 0, 0, 0);
                            S1 = __builtin_amdgcn_mfma_f32_16x16x32_f16(a1, qf[ks], S1, 0, 0, 0);
                        }
                        const u16x8 myi = *(const LAS u16x8*)(idxq + chunk * 32 + 8 * g);
                        float lg[8];
#pragma unroll
                        for (int j = 0; j < 8; ++j) { const int s = (int)myi[j]; int dist = t - s; dist = dist > 128 ? 128 : dist; const float sv = (j < 4) ? S0[j & 3] : S1[j & 3];
                            lg[j] = (chunk * 32 + 8 * g + j < cnt) ? sv + rbh[dist] : NEG_INF; }
                        float mx = fmaxf(fmaxf(fmaxf(lg[0], lg[1]), fmaxf(lg[2], lg[3])), fmaxf(fmaxf(lg[4], lg[5]), fmaxf(lg[6], lg[7])));
                        mx = fmaxf(mx, __shfl_xor(mx, 16)); mx = fmaxf(mx, __shfl_xor(mx, 32));
                        const float m_new = fmaxf(m_run, mx); const float scl = __expf(m_run - m_new); m_run = m_new;
                        float pr[8]; float ps = 0.f;
#pragma unroll
                        for (int j = 0; j < 8; ++j) { pr[j] = __expf(lg[j] - m_new); ps += pr[j]; }
                        l_part = l_part * scl + ps;
                        f16x8 pb;
#pragma unroll
                        for (int j = 0; j < 8; ++j) pb[j] = (f16)pr[j];
#pragma unroll
                        for (int ct = 0; ct < 8; ++ct) {
                            const v4i16 t0 = __builtin_amdgcn_ds_read_tr16_b64_v4i16((LAS v4i16*)(gb + tr_addr16(lane_o, ct, 0)));
                            const v4i16 t1 = __builtin_amdgcn_ds_read_tr16_b64_v4i16((LAS v4i16*)(gb + tr_addr16(lane_o, ct, 1)));
                            const v8i16 av = (v8i16){t0[0], t0[1], t0[2], t0[3], t1[0], t1[1], t1[2], t1[3]};
                            o[ct] = o[ct] * scl;
                            o[ct] = __builtin_amdgcn_mfma_f32_16x16x32_f16(__builtin_bit_cast(f16x8, av), pb, o[ct], 0, 0, 0);
                        }
                      }
                    }
                    float l_tot = l_part; l_tot += __shfl_xor(l_tot, 16); l_tot += __shfl_xor(l_tot, 32);
                    const float inv = 1.f / l_tot;
                    if (head < 8) {
                        f16* op = (f16*)MIX + (size_t)m * MIXK + 512 + head * 128 + 4 * g;
#pragma unroll
                        for (int ct = 0; ct < 8; ++ct) { u32x2 w; w.x = pk2h(o[ct][0] * inv, o[ct][1] * inv); w.y = pk2h(o[ct][2] * inv, o[ct][3] * inv); *(u32x2*)(op + 16 * ct) = w; }
                    }
                }
            }
        }
    }
    GSYNC();

    if (PHM & 64) {
        pg8::Gemm g{MIX, BT_O, M, D, MIXK}; pg8::StaticOrder S; S.init(M, D, G, (int)blockIdx.x);
        pg8::EpiPre E{X16, PRE, D, p.in[I_B_O], DN_ALPHA};
        pg8::gemm_phase<pg8::EpiPre, pg8::StaticOrder, true, true>(lds, g, S, E);
    }
    GSYNC();
    for (int m = gw; m < M; m += NGW) ln_row<true>(PRE + (size_t)m * D, p.in[I_LN1_G], p.in[I_LN1_B], X16 + (size_t)m * D, lane);
    GSYNC();

    if (PHM & 128) {
        pg8::Gemm g{X16, BT_Q, M, D, D}; pg8::StaticOrder S; S.init(M, D, G, (int)blockIdx.x);
        pg8::EpiF16<0> E{Q2, D, p.in[I_BQ]};
        pg8::gemm_phase<pg8::EpiF16<0>, pg8::StaticOrder, true, true>(lds, g, S, E);
    }
    GSYNC();

    if (PHM & 256) {
        LAS unsigned char* Ks = lds;
        LAS unsigned char* Vs = lds + 32768;
        const int q16 = lane & 15, g = lane >> 4;
        for (int unit = blockIdx.x; unit < 1024; unit += G) {
            const int qblk = unit & 31, head = (unit >> 5) & 3, b = unit >> 7;
            const size_t mrow = (size_t)b * T + qblk * 128 + wave * 16 + q16;
            f16x8 qf[8];
#pragma unroll
            for (int ks = 0; ks < 8; ++ks) qf[ks] = *(const f16x8*)((const f16*)Q2 + mrow * D + head * 256 + 32 * ks + 8 * g);
            f32x4 o[16];
#pragma unroll
            for (int dt = 0; dt < 16; ++dt) o[dt] = (f32x4){0.f, 0.f, 0.f, 0.f};
            float m_run = -3.0e38f, l_part = 0.f;
#pragma unroll 1
            for (int c = 0; c < 4; ++c) {
                __syncthreads();
#pragma unroll
                for (int i = 0; i < 4; ++i) {
                    const int pz = tid + 512 * i;
                    { const int r = pz >> 5, ch = pz & 31;
                      const u32x4 v = *(const u32x4*)((const f16*)KM + (size_t)(b * MEML + 64 * c + r) * D + head * 256 + 8 * ch);
                      *(LAS u32x4*)(Ks + r * 512 + ((ch ^ (r & 15)) << 4)) = v; }
                    { const int d = pz >> 3, pc = pz & 7;
                      const u32x4 v = *(const u32x4*)((const f16*)VT + (size_t)((b * 4 + head) * 256 + d) * MEML + 64 * c + 8 * pc);
                      *(LAS u32x4*)(Vs + d * 144 + pc * 16) = v; }
                }
                __syncthreads();
                f32x4 S[4];
#pragma unroll
                for (int u = 0; u < 4; ++u) {
                    S[u] = (f32x4){0.f, 0.f, 0.f, 0.f};
#pragma unroll
                    for (int ks = 0; ks < 8; ++ks) {
                        const f16x8 a = *(const LAS f16x8*)(Ks + (16 * u + q16) * 512 + (((4 * ks + g) ^ q16) << 4));
                        S[u] = __builtin_amdgcn_mfma_f32_16x16x32_f16(a, qf[ks], S[u], 0, 0, 0);
                    }
                }
                float mx = -3.0e38f;
#pragma unroll
                for (int u = 0; u < 4; ++u)
#pragma unroll
                    for (int r = 0; r < 4; ++r) { S[u][r] *= 0.0625f; mx = fmaxf(mx, S[u][r]); }
                mx = fmaxf(mx, __shfl_xor(mx, 16)); mx = fmaxf(mx, __shfl_xor(mx, 32));
                const float m_new = fmaxf(m_run, mx); const float scl = __expf(m_run - m_new); m_run = m_new;
                float ps = 0.f;
#pragma unroll
                for (int u = 0; u < 4; ++u)
#pragma unroll
                    for (int r = 0; r < 4; ++r) { S[u][r] = __expf(S[u][r] - m_new); ps += S[u][r]; }
                l_part = l_part * scl + ps;
                f16x8 pb[2];
#pragma unroll
                for (int v = 0; v < 2; ++v)
#pragma unroll
                    for (int j = 0; j < 4; ++j) { pb[v][j] = (f16)S[2 * v][j]; pb[v][4 + j] = (f16)S[2 * v + 1][j]; }
#pragma unroll
                for (int dt = 0; dt < 16; ++dt) {
                    o[dt] = o[dt] * scl;
#pragma unroll
                    for (int v = 0; v < 2; ++v) {
                        const LAS unsigned char* vp = Vs + (16 * dt + q16) * 144 + (32 * v + 4 * g) * 2;
                        const f16x4 v0 = *(const LAS f16x4*)vp, v1 = *(const LAS f16x4*)(vp + 32);
                        const f16x8 av = (f16x8){v0[0], v0[1], v0[2], v0[3], v1[0], v1[1], v1[2], v1[3]};
                        o[dt] = __builtin_amdgcn_mfma_f32_16x16x32_f16(av, pb[v], o[dt], 0, 0, 0);
                    }
                }
            }
            float l_tot = l_part; l_tot += __shfl_xor(l_tot, 16); l_tot += __shfl_xor(l_tot, 32);
            const float inv = 1.f / l_tot;
            f16* op = (f16*)O2 + mrow * D + head * 256 + 4 * g;
#pragma unroll
            for (int dt = 0; dt < 16; ++dt) { u32x2 w; w.x = pk2h(o[dt][0] * inv, o[dt][1] * inv); w.y = pk2h(o[dt][2] * inv, o[dt][3] * inv); *(u32x2*)(op + 16 * dt) = w; }
        }
    }
    GSYNC();

    if (PHM & 512) {
        pg8::Gemm g{O2, BT_WO, M, D, D}; pg8::StaticOrder S; S.init(M, D, G, (int)blockIdx.x);
        pg8::EpiPre E{X16, PRE, D, p.in[I_BO], DN_ALPHA};
        pg8::gemm_phase<pg8::EpiPre, pg8::StaticOrder, true, true>(lds, g, S, E);
    }
    GSYNC();
    for (int m = gw; m < M; m += NGW) ln_row<true>(PRE + (size_t)m * D, p.in[I_LN2_G], p.in[I_LN2_B], X16 + (size_t)m * D, lane);
    GSYNC();

    if (PHM & 1024) {
        pg8::Gemm g{X16, BT_UP, M, FF, D}; pg8::StaticOrder S; S.init(M, FF, G, (int)blockIdx.x);
        pg8::EpiF16<2> E{HFF, FF, p.in[I_B_UP]};
        pg8::gemm_phase<pg8::EpiF16<2>, pg8::StaticOrder, true, true>(lds, g, S, E);
    }
    GSYNC();
    if (PHM & 2048) {
        pg8::Gemm g{HFF, BT_DN, M, D, FF}; pg8::StaticOrder S; S.init(M, D, G, (int)blockIdx.x);
        pg8::EpiPre E{X16, PRE, D, p.in[I_B_DN], DN_ALPHA};
        pg8::gemm_phase<pg8::EpiPre, pg8::StaticOrder, true, true>(lds, g, S, E);
    }
    GSYNC();
    for (int m = gw; m < M; m += NGW) ln_row<false>(PRE + (size_t)m * D, p.in[I_LN3_G], p.in[I_LN3_B], p.out + (size_t)m * D, lane);
}

extern "C" void kernel_launch(void* const* d_in, const int* in_sizes, int n_in, void* d_out, int out_size, void* d_ws, size_t ws_size, hipStream_t stream) {
    static int grid = 0;
    if (grid == 0) {
        if (n_in != 31 || out_size != M * D || ws_size < WS_END) { fprintf(stderr, "kernel_launch: unexpected shapes (n_in %d, out %d, ws %zu)\n", n_in, out_size, ws_size); grid = -1; return; }
        int dev = 0, cus = 0, per_cu = 0;
        hipGetDevice(&dev); hipDeviceGetAttribute(&cus, hipDeviceAttributeMultiprocessorCount, dev);
        hipFuncSetAttribute((const void*)fwd_kernel, hipFuncAttributeMaxDynamicSharedMemorySize, LDS_BYTES);
        hipOccupancyMaxActiveBlocksPerMultiprocessor(&per_cu, (const void*)fwd_kernel, NTHREADS, LDS_BYTES);
        if (per_cu < 1) { fprintf(stderr, "kernel_launch: occupancy query says %d blocks per CU\n", per_cu); grid = -1; return; }
        grid = cus;
    }
    if (grid < 0) return;
    hipMemsetAsync((char*)d_ws + WS_CTL, 0, CTL_BYTES, stream);
    Params p{};
    for (int i = 0; i < 31; ++i) p.in[i] = (const float*)d_in[i];
    p.out = (float*)d_out; p.ws = (unsigned char*)d_ws;
    void* args[] = {&p};
    hipError_t e = hipLaunchCooperativeKernel((const void*)fwd_kernel, dim3(grid), dim3(NTHREADS), args, LDS_BYTES, stream);
    if (e != hipSuccess) fprintf(stderr, "cooperative launch failed: %s (grid %d)\n", hipGetErrorString(e), grid);
}
```

```cpp
#include <hip/hip_runtime.h>
#include <hip/hip_cooperative_groups.h>
#include <cstdio>
#include <cstdint>
namespace cg = cooperative_groups;

namespace pg8 {
#define PG8_LAS __attribute__((address_space(3)))
typedef unsigned short bf16_t;
typedef _Float16 bf16x8 __attribute__((ext_vector_type(8)));
typedef float f32x4 __attribute__((ext_vector_type(4)));
typedef unsigned u32x4 __attribute__((ext_vector_type(4)));
typedef unsigned u32x2 __attribute__((ext_vector_type(2)));
typedef float f32x2 __attribute__((ext_vector_type(2)));
typedef _Float16 f16x2 __attribute__((ext_vector_type(2)));
typedef _Float16 f16x4 __attribute__((ext_vector_type(4)));
constexpr int BM = 256, BK = 64, HALF = 128, HTB = HALF * BK * 2, STAGE_BYTES = 8 * HTB, NXCD = 8, WGM = 8;

__host__ __device__ __forceinline__ int lds_byte(int r, int c) { const int st = (r >> 4) * 2 + (c >> 5), rr = r & 15, cc = c & 31, ob = rr * 64 + cc * 2; return st * 1024 + (ob ^ (((ob >> 9) & 1) << 5)); }
__host__ __device__ __forceinline__ void stage_rc(int b, int& R, int& C) { const int st = b / 1024, sb = b % 1024, swz = sb ^ (((sb >> 9) & 1) << 5); R = (st >> 1) * 16 + swz / 64; C = (st & 1) * 32 + (swz % 64) / 2; }
__host__ __device__ __forceinline__ int perm32(int rho) { const int n = rho >> 4, i = rho & 15; return 8 * (i >> 2) + 4 * n + (i & 3); }

struct Unit { int pm, pn; };
struct Gemm { const bf16_t* A; const bf16_t* Bt; int M, N, K; };

struct StaticOrder {
    int nM, nN, nwg, G, c;
    __host__ __device__ void init(int M, int N, int G_, int c_) { nM = M / BM; nN = N / BM; nwg = nM * nN; G = G_; c = c_; }
    __host__ __device__ bool next(int i, Unit& u) const {
        const long L = (long)i * G + c; if (L >= nwg) return false;
        int wgid = (int)L; { const int q = nwg / NXCD, r = nwg % NXCD, xcd = wgid % NXCD, off = wgid / NXCD; wgid = (xcd < r ? xcd * (q + 1) : r * (q + 1) + (xcd - r) * q) + off; }
        const int nig = WGM * nN, gid = wgid / nig, fm = gid * WGM, gsz = (nM - fm) < WGM ? (nM - fm) : WGM;
        u.pm = fm + ((wgid % nig) % gsz); u.pn = (wgid % nig) / gsz; return true;
    }
    __device__ __forceinline__ void a_ready(const Unit&) const {}
    __device__ __forceinline__ void done(const Unit&) const {}
};

__device__ __forceinline__ unsigned pk_f16(float lo, float hi) { f32x2 v = {lo, hi}; f16x2 h = __builtin_convertvector(v, f16x2); return __builtin_bit_cast(unsigned, h); }

template <int ACT  > struct EpiF16 {
    static constexpr bool PERM = true, AFTER_DRAIN = false;
    bf16_t* O; int ldc; const float* bias;
    __device__ __forceinline__ void operator()(const f32x4 (&acc)[2][2][4][2], const Unit& u, int wr, int wc, int fr, int fq) const {
        const int row0 = u.pm * BM + wr * 64 + fr; const int col0 = u.pn * BM + wc * 32 + 8 * fq;
        f32x4 bv[2][2];
#pragma unroll
        for (int bj = 0; bj < 2; ++bj)
#pragma unroll
            for (int n = 0; n < 2; ++n) bv[bj][n] = *(const f32x4*)(bias + col0 + bj * HALF + 4 * n);
#pragma unroll
        for (int ai = 0; ai < 2; ++ai)
#pragma unroll
            for (int m = 0; m < 4; ++m) { bf16_t* rowp = O + (size_t)(row0 + ai * HALF + m * 16) * ldc + col0;
#pragma unroll
                for (int bj = 0; bj < 2; ++bj) { f32x4 v0 = acc[ai][bj][m][0] + bv[bj][0], v1 = acc[ai][bj][m][1] + bv[bj][1];
                    if (ACT == 2) {
#pragma unroll
                        for (int e = 0; e < 4; ++e) { const float a = fmaxf(v0[e], 0.f), b = fmaxf(v1[e], 0.f); v0[e] = a * a; v1[e] = b * b; } }
                    u32x4 w; w.x = pk_f16(v0[0], v0[1]); w.y = pk_f16(v0[2], v0[3]); w.z = pk_f16(v1[0], v1[1]); w.w = pk_f16(v1[2], v1[3]);
                    *(u32x4*)(rowp + bj * HALF) = w; } }
    }
};
struct EpiIn {
    static constexpr bool PERM = true, AFTER_DRAIN = false;
    bf16_t* O; int ldc; const float* bias; float* RAW; int rawt;
    __device__ __forceinline__ void operator()(const f32x4 (&acc)[2][2][4][2], const Unit& u, int wr, int wc, int fr, int fq) const {
        const int row0 = u.pm * BM + wr * 64 + fr; const int col0 = u.pn * BM + wc * 32 + 8 * fq;
        f32x4 bv[2][2];
#pragma unroll
        for (int bj = 0; bj < 2; ++bj)
#pragma unroll
            for (int n = 0; n < 2; ++n) bv[bj][n] = *(const f32x4*)(bias + col0 + bj * HALF + 4 * n);
        const bool raw = (u.pn == rawt);
#pragma unroll
        for (int ai = 0; ai < 2; ++ai)
#pragma unroll
            for (int m = 0; m < 4; ++m) { const size_t row = (size_t)(row0 + ai * HALF + m * 16); bf16_t* rowp = O + row * ldc + col0; float* rawp = RAW + row * 256 + wc * 32 + 8 * fq;
#pragma unroll
                for (int bj = 0; bj < 2; ++bj) { const f32x4 v0 = acc[ai][bj][m][0] + bv[bj][0], v1 = acc[ai][bj][m][1] + bv[bj][1];
                    if (raw) { *(f32x4*)(rawp + bj * HALF) = v0; *(f32x4*)(rawp + bj * HALF + 4) = v1; }
                    else { u32x4 w; w.x = pk_f16(v0[0], v0[1]); w.y = pk_f16(v0[2], v0[3]); w.z = pk_f16(v1[0], v1[1]); w.w = pk_f16(v1[2], v1[3]);
                        *(u32x4*)(rowp + bj * HALF) = w; } } }
    }
};
struct EpiKV {
    static constexpr bool PERM = true, AFTER_DRAIN = false;
    bf16_t* KM; bf16_t* VT; const float* bias;
    __device__ __forceinline__ void operator()(const f32x4 (&acc)[2][2][4][2], const Unit& u, int wr, int wc, int fr, int fq) const {
        const int col0 = u.pn * BM + wc * 32 + 8 * fq;
        f32x4 bv[2][2];
#pragma unroll
        for (int bj = 0; bj < 2; ++bj)
#pragma unroll
            for (int n = 0; n < 2; ++n) bv[bj][n] = *(const f32x4*)(bias + col0 + bj * HALF + 4 * n);
        const bool isv = u.pn >= 4;
#pragma unroll
        for (int ai = 0; ai < 2; ++ai)
#pragma unroll
            for (int m = 0; m < 4; ++m) { const int j = wr * 64 + fr + ai * HALF + m * 16;
#pragma unroll
                for (int bj = 0; bj < 2; ++bj) { const f32x4 v0 = acc[ai][bj][m][0] + bv[bj][0], v1 = acc[ai][bj][m][1] + bv[bj][1];
                    if (!isv) { u32x4 w; w.x = pk_f16(v0[0], v0[1]); w.y = pk_f16(v0[2], v0[3]); w.z = pk_f16(v1[0], v1[1]); w.w = pk_f16(v1[2], v1[3]);
                        *(u32x4*)(KM + (size_t)(u.pm * BM + j) * 1024 + col0 + bj * HALF) = w; }
                    else { _Float16* vt = (_Float16*)VT + ((size_t)(u.pm * 4 + (u.pn - 4)) * 256 + (wc * 32 + 8 * fq + bj * HALF)) * 256 + j;
#pragma unroll
                        for (int e = 0; e < 4; ++e) { vt[(size_t)e * 256] = (_Float16)v0[e]; vt[(size_t)(4 + e) * 256] = (_Float16)v1[e]; } } } }
    }
};
struct EpiPre {
    static constexpr bool PERM = false, AFTER_DRAIN = false;
    const bf16_t* base; float* out; int ldc; const float* bias; float alpha;
    __device__ __forceinline__ void operator()(const f32x4 (&acc)[2][2][4][2], const Unit& u, int wr, int wc, int fr, int fq) const {
        const int col0 = u.pn * BM + wc * 32 + 4 * fq;
        f32x4 bv[2][2];
#pragma unroll
        for (int bj = 0; bj < 2; ++bj)
#pragma unroll
            for (int n = 0; n < 2; ++n) bv[bj][n] = *(const f32x4*)(bias + col0 + bj * HALF + n * 16);
#pragma unroll
        for (int ai = 0; ai < 2; ++ai)
#pragma unroll
            for (int m = 0; m < 4; ++m) { const size_t off = (size_t)(u.pm * BM + ai * HALF + wr * 64 + m * 16 + fr) * ldc + col0;
#pragma unroll
                for (int bj = 0; bj < 2; ++bj)
#pragma unroll
                    for (int n = 0; n < 2; ++n) { const f16x4 bs = *(const f16x4*)(base + off + bj * HALF + n * 16);
                        f32x4 v = acc[ai][bj][m][n] + bv[bj][n];
#pragma unroll
                        for (int e = 0; e < 4; ++e) v[e] += alpha * (float)bs[e];
                        *(f32x4*)(out + off + bj * HALF + n * 16) = v; } }
    }
};

template <class Epi, class Sched, bool ALIGN_EPI = false, bool SP2 = false>
__device__ __forceinline__ void gemm_phase(PG8_LAS unsigned char* lds, const Gemm g, const Sched& S, const Epi& E) {
    int tid_ = threadIdx.x; asm volatile("" : "+v"(tid_));
    const int tid = tid_, wid = __builtin_amdgcn_readfirstlane(tid >> 6), lane = tid & 63, wr = wid >> 2, wc = wid & 3, fr = lane & 15, fq = lane >> 4;
    const int K = g.K, nt = K / BK;
    unsigned voffA[2], voffB[2];
#pragma unroll
    for (int i = 0; i < 2; ++i) { int R, C; stage_rc(tid * 16 + i * 8192, R, C); const int Rb = Epi::PERM ? ((R & ~31) + perm32(R & 31)) : R;
        voffA[i] = (unsigned)(R * K + C) * 2u; voffB[i] = (unsigned)(Rb * K + C) * 2u; }
    const size_t kstep = (size_t)(BK * 2);
    const size_t hstep = (size_t)HALF * K * 2;
    const size_t tstep = 2 * hstep;
    const unsigned ldsw = (unsigned)wid * 1024u;
    const int aoff = lds_byte(wr * 64 + fr, fq * 8), boff = lds_byte(wc * 32 + fr, fq * 8);
#define PG8_SA(b, h) (((b) * 2 + (h)) * HTB)
#define PG8_SB(b, h) ((4 + (b) * 2 + (h)) * HTB)
#define PG8_STAGE(bufoff, gbase, voff) do { _Pragma("unroll") for (int _i = 0; _i < 2; ++_i) \
        __builtin_amdgcn_global_load_lds((const unsigned*)((const char*)(gbase) + (voff)[_i]), (PG8_LAS unsigned*)(lds + (bufoff) + ldsw + _i * 8192), 16, 0, 0); } while (0)
#define PG8_LDA(dst, b, h) do { _Pragma("unroll") for (int m = 0; m < 4; ++m) _Pragma("unroll") for (int k = 0; k < 2; ++k) dst[m][k] = *(const PG8_LAS bf16x8*)(lds + PG8_SA(b, h) + aoff + m * 2048 + k * 1024); } while (0)
#define PG8_LDB(dst, b, h) do { _Pragma("unroll") for (int n = 0; n < 2; ++n) _Pragma("unroll") for (int k = 0; k < 2; ++k) dst[n][k] = *(const PG8_LAS bf16x8*)(lds + PG8_SB(b, h) + boff + n * 2048 + k * 1024); } while (0)
#define PG8_MMA(ai, bj, At, Bt) do { __builtin_amdgcn_s_setprio(1); _Pragma("unroll") for (int m = 0; m < 4; ++m) _Pragma("unroll") for (int n = 0; n < 2; ++n) _Pragma("unroll") for (int k = 0; k < 2; ++k) \
        acc[ai][bj][m][n] = __builtin_amdgcn_mfma_f32_16x16x32_f16(Bt[n][k], At[m][k], acc[ai][bj][m][n], 0, 0, 0); __builtin_amdgcn_s_setprio(0); } while (0)
#define PG8_WAIT_V(n) asm volatile("s_waitcnt vmcnt(" #n ")" ::: "memory")
#define PG8_WAIT_L(n) asm volatile("s_waitcnt lgkmcnt(" #n ")" ::: "memory")
#define PG8_BAR __builtin_amdgcn_s_barrier()
#define PG8_SCHED __builtin_amdgcn_sched_barrier(0)
    Unit cur, nxt; int ui = 0;
    if (!S.next(0, cur)) return;
    f32x4 acc[2][2][4][2];
#pragma unroll
    for (int a = 0; a < 2; ++a)
#pragma unroll
        for (int b = 0; b < 2; ++b)
#pragma unroll
            for (int m = 0; m < 4; ++m)
#pragma unroll
                for (int n = 0; n < 2; ++n) acc[a][b][m][n] = (f32x4){0.f, 0.f, 0.f, 0.f};
    bf16x8 At[4][2], B0[2][2], B1[2][2];
    const char* cA = (const char*)g.A + (size_t)cur.pm * tstep; const char* cB = (const char*)g.Bt + (size_t)cur.pn * tstep;
    S.a_ready(cur);
    if constexpr (SP2) {
        PG8_STAGE(PG8_SB(0, 0), cB, voffB); PG8_STAGE(PG8_SB(0, 1), cB + hstep, voffB); PG8_STAGE(PG8_SA(0, 0), cA, voffA); PG8_STAGE(PG8_SA(0, 1), cA + hstep, voffA);
        if (wr == 1) PG8_BAR;
        PG8_WAIT_V(2); PG8_BAR;
        PG8_STAGE(PG8_SB(1, 0), cB + kstep, voffB); PG8_STAGE(PG8_SA(1, 0), cA + kstep, voffA); PG8_STAGE(PG8_SB(1, 1), cB + hstep + kstep, voffB);
        PG8_WAIT_V(6); PG8_BAR;
    } else {
        PG8_STAGE(PG8_SB(0, 0), cB, voffB); PG8_STAGE(PG8_SA(0, 0), cA, voffA); PG8_STAGE(PG8_SB(0, 1), cB + hstep, voffB); PG8_STAGE(PG8_SA(0, 1), cA + hstep, voffA);
        if (wr == 1) PG8_BAR;
        PG8_WAIT_V(4); PG8_BAR;
        PG8_STAGE(PG8_SB(1, 0), cB + kstep, voffB); PG8_STAGE(PG8_SA(1, 0), cA + kstep, voffA); PG8_STAGE(PG8_SB(1, 1), cB + hstep + kstep, voffB);
        PG8_WAIT_V(6); PG8_BAR;
    }
    for (;;) {
        const bool has_next = S.next(ui + 1, nxt);
        const char* nA = has_next ? (const char*)g.A + (size_t)nxt.pm * tstep : cA; const char* nB = has_next ? (const char*)g.Bt + (size_t)nxt.pn * tstep : cB;
        for (int t = 0; t < nt; t += 2) {
            const bool last = (t == nt - 2);
            const char* a1 = cA + (size_t)(t + 1) * kstep;
            const char* a2 = last ? nA : cA + (size_t)(t + 2) * kstep; const char* b2 = last ? nB : cB + (size_t)(t + 2) * kstep;
            const char* a3 = a2 + kstep; const char* b3 = b2 + kstep;
            if (last && has_next) S.a_ready(nxt);
            if constexpr (SP2) {
            PG8_LDB(B0, 0, 0); PG8_LDB(B1, 0, 1); PG8_SCHED; PG8_LDA(At, 0, 0); PG8_STAGE(PG8_SA(1, 1), a1 + hstep, voffA);
            PG8_WAIT_V(8); PG8_WAIT_L(0); PG8_BAR; PG8_MMA(0, 0, At, B0); PG8_MMA(0, 1, At, B1); PG8_BAR; PG8_SCHED;
            PG8_LDA(At, 0, 1); PG8_STAGE(PG8_SB(0, 0), b2, voffB); PG8_STAGE(PG8_SB(0, 1), b2 + hstep, voffB); PG8_STAGE(PG8_SA(0, 0), a2, voffA);
            PG8_WAIT_V(8); PG8_WAIT_L(0); PG8_BAR; PG8_MMA(1, 0, At, B0); PG8_MMA(1, 1, At, B1); PG8_BAR; PG8_SCHED;
            PG8_LDB(B0, 1, 0); PG8_LDB(B1, 1, 1); PG8_SCHED; PG8_LDA(At, 1, 0); PG8_STAGE(PG8_SA(0, 1), a2 + hstep, voffA);
            PG8_WAIT_V(8); PG8_WAIT_L(0); PG8_BAR; PG8_MMA(0, 0, At, B0); PG8_MMA(0, 1, At, B1); PG8_BAR; PG8_SCHED;
            PG8_LDA(At, 1, 1); PG8_STAGE(PG8_SB(1, 0), b3, voffB); PG8_STAGE(PG8_SB(1, 1), b3 + hstep, voffB); PG8_STAGE(PG8_SA(1, 0), a3, voffA);
            PG8_WAIT_V(8); PG8_WAIT_L(0); PG8_BAR; PG8_MMA(1, 0, At, B0); PG8_MMA(1, 1, At, B1); PG8_BAR; PG8_SCHED;
            } else {
            PG8_LDB(B0, 0, 0); PG8_SCHED; PG8_LDA(At, 0, 0); PG8_STAGE(PG8_SA(1, 1), a1 + hstep, voffA);
            PG8_WAIT_L(8); PG8_BAR; PG8_WAIT_L(0); PG8_MMA(0, 0, At, B0); PG8_BAR; PG8_SCHED;
            PG8_LDB(B1, 0, 1); PG8_STAGE(PG8_SB(0, 0), b2, voffB);
            PG8_BAR; PG8_WAIT_L(0); PG8_MMA(0, 1, At, B1); PG8_BAR;
            PG8_LDA(At, 0, 1); PG8_STAGE(PG8_SA(0, 0), a2, voffA);
            PG8_BAR; PG8_WAIT_L(0); PG8_MMA(1, 0, At, B0); PG8_BAR; PG8_SCHED;
            PG8_STAGE(PG8_SB(0, 1), b2 + hstep, voffB);
            PG8_WAIT_V(6); PG8_BAR; PG8_MMA(1, 1, At, B1); PG8_BAR;
            PG8_LDB(B0, 1, 0); PG8_SCHED; PG8_LDA(At, 1, 0); PG8_STAGE(PG8_SA(0, 1), a2 + hstep, voffA);
            PG8_WAIT_L(8); PG8_BAR; PG8_WAIT_L(0); PG8_MMA(0, 0, At, B0); PG8_BAR; PG8_SCHED;
            PG8_LDB(B1, 1, 1); PG8_STAGE(PG8_SB(1, 0), b3, voffB);
            PG8_BAR; PG8_WAIT_L(0); PG8_MMA(0, 1, At, B1); PG8_BAR;
            PG8_LDA(At, 1, 1); PG8_STAGE(PG8_SA(1, 0), a3, voffA);
            PG8_BAR; PG8_WAIT_L(0); PG8_MMA(1, 0, At, B0); PG8_BAR; PG8_SCHED;
            PG8_STAGE(PG8_SB(1, 1), b3 + hstep, voffB);
            PG8_WAIT_V(6); PG8_BAR; PG8_MMA(1, 1, At, B1); PG8_BAR;
            }
        }
        if constexpr (ALIGN_EPI) { if (wr == 0) PG8_BAR; }
        if constexpr (!Epi::AFTER_DRAIN) { E(acc, cur, wr, wc, fr, fq); S.done(cur); }
        if (!has_next) break;
#pragma unroll
        for (int a = 0; a < 2; ++a)
#pragma unroll
            for (int b = 0; b < 2; ++b)
#pragma unroll
                for (int m = 0; m < 4; ++m)
#pragma unroll
                    for (int n = 0; n < 2; ++n) acc[a][b][m][n] = (f32x4){0.f, 0.f, 0.f, 0.f};
        cur = nxt; cA = nA; cB = nB; ++ui;
        if constexpr (ALIGN_EPI) { if (wr == 1) PG8_BAR; }
    }
    PG8_WAIT_V(0);
    if constexpr (!ALIGN_EPI) { if (wr == 0) PG8_BAR; }
    PG8_BAR;
    if constexpr (Epi::AFTER_DRAIN) { E.fused(acc, cur, wr, wc, fr, fq, lds, wid, lane); S.done(cur); }
#undef PG8_SA
#undef PG8_SB
#undef PG8_STAGE
#undef PG8_LDA
#undef PG8_LDB
#undef PG8_MMA
#undef PG8_WAIT_V
#undef PG8_WAIT_L
#undef PG8_BAR
#undef PG8_SCHED
}

}

constexpr int NB = 8, T = 4096, M = NB * T, D = 1024, DIN = 1992, NIN = 2560, MIXK = 1536, FF = 4096, MEML = 256, MROWS = NB * MEML;
constexpr int RAWT = 7;
constexpr float LN_EPS = 1e-5f, DN_ALPHA = 1.189207115002721f;
constexpr float NEG_INF = -1e30f;
constexpr size_t MiB = 1u << 20;
constexpr size_t WS_CTL = 0, CTL_BYTES = 1 * MiB;
constexpr size_t WS_RELB = 1 * MiB;
constexpr size_t WS_BINP = 1 * MiB + 65536;
constexpr size_t WS_BT_IN = 2 * MiB, WS_BT_O = 7 * MiB, WS_BT_Q = 10 * MiB, WS_BT_KV = 12 * MiB, WS_BT_WO = 16 * MiB, WS_BT_UP = 18 * MiB, WS_BT_DN = 26 * MiB;
constexpr size_t WS_MEM16 = 34 * MiB, WS_KVM = 38 * MiB;
constexpr size_t WS_X16 = 48 * MiB, WS_MIX = 112 * MiB, WS_H = 208 * MiB, WS_RAW = 368 * MiB, WS_SCR = 368 * MiB, WS_CB = 496 * MiB, WS_IK = 504 * MiB, WS_IW = 508 * MiB;
constexpr size_t WS_Q2 = 208 * MiB, WS_O2 = 272 * MiB, WS_HFF = 208 * MiB, WS_END = 510 * MiB;

typedef unsigned short h16;
typedef _Float16 f16;
typedef _Float16 f16x2 __attribute__((ext_vector_type(2)));
typedef _Float16 f16x4 __attribute__((ext_vector_type(4)));
typedef _Float16 f16x8 __attribute__((ext_vector_type(8)));
typedef float f32x4 __attribute__((ext_vector_type(4)));
typedef float f32x2 __attribute__((ext_vector_type(2)));
typedef unsigned u32x4 __attribute__((ext_vector_type(4)));
typedef unsigned u32x2 __attribute__((ext_vector_type(2)));
#define LAS __attribute__((address_space(3)))
typedef float f32x16 __attribute__((ext_vector_type(16)));
typedef short v4i16 __attribute__((ext_vector_type(4)));
typedef short v8i16 __attribute__((ext_vector_type(8)));
typedef unsigned short u16x8 __attribute__((ext_vector_type(8)));
__device__ __forceinline__ unsigned off_b(unsigned row, unsigned ch) { return 256u * row + 16u * (ch ^ (((row & 3) << 2) | ((row >> 2) & 3))); }
__device__ __forceinline__ unsigned tr_addr16(unsigned lane, unsigned c, unsigned t) { const unsigned g = lane >> 4, q = (lane & 15) >> 2, p = lane & 3; return off_b(8 * g + 4 * t + q, 2 * c + (p >> 1)) + 8 * (p & 1); }

__device__ const unsigned char REL_BUCKET[129] = {0, 1, 2, 3, 4, 5, 6, 7, 8, 9, 10, 11, 12, 13, 14, 15, 16, 16, 16, 17, 17, 18, 18, 18, 19, 19, 19, 20, 20, 20, 20, 21, 21, 21, 21, 22, 22, 22, 22, 22, 23, 23, 23, 23, 23, 23, 24, 24, 24, 24, 24, 24, 25, 25, 25, 25, 25, 25, 25, 26, 26, 26, 26, 26, 26, 26, 26, 27, 27, 27, 27, 27, 27, 27, 27, 27, 27, 28, 28, 28, 28, 28, 28, 28, 28, 28, 28, 29, 29, 29, 29, 29, 29, 29, 29, 29, 29, 29, 29, 30, 30, 30, 30, 30, 30, 30, 30, 30, 30, 30, 30, 30, 30, 31, 31, 31, 31, 31, 31, 31, 31, 31, 31, 31, 31, 31, 31, 31, 31};

struct Params { const float* in[31]; float* out; unsigned char* ws; };
enum { I_X = 0, I_MEM, I_LNE_G, I_LNE_B, I_W_IN, I_B_IN, I_SINKS, I_KVN_G, I_W_UK, I_W_UV, I_IKLN_G, I_IKLN_B, I_REL, I_W_O, I_B_O, I_LN1_G, I_LN1_B, I_WQ, I_BQ, I_WKV, I_BKV, I_WO, I_BO,
       I_LN2_G, I_LN2_B, I_W_UP, I_B_UP, I_W_DN, I_B_DN, I_LN3_G, I_LN3_B };

__device__ __forceinline__ float wave_sum(float v) {
#pragma unroll
    for (int o = 1; o < 64; o <<= 1) v += __shfl_xor(v, o);
    return v;
}
__device__ __forceinline__ float wave_max(float v) {
#pragma unroll
    for (int o = 1; o < 64; o <<= 1) v = fmaxf(v, __shfl_xor(v, o));
    return v;
}
__device__ __forceinline__ int wave_sum_i(int v) {
#pragma unroll
    for (int o = 1; o < 64; o <<= 1) v += __shfl_xor(v, o);
    return v;
}
__device__ __forceinline__ unsigned pk2h(float lo, float hi) { return pg8::pk_f16(lo, hi); }
__device__ __forceinline__ float ld_sc1(const float* p) { return __hip_atomic_load(p, __ATOMIC_RELAXED, __HIP_MEMORY_SCOPE_AGENT); }

__device__ __forceinline__ void p0_transpose_item(const float* W, int ldw, int col0, h16* WT, int ldd, int row0, int nblk, LAS float* scr, int item, int lane) {
    const int kb = item / nblk, nb = item % nblk, k0 = 64 * kb, n0 = 32 * nb;
#pragma unroll 8
    for (int i = 0; i < 32; ++i) { const int kk = 2 * i + (lane >> 5); scr[kk * 33 + (lane & 31)] = W[(size_t)(k0 + kk) * ldw + col0 + n0 + (lane & 31)]; }
    asm volatile("s_waitcnt lgkmcnt(0)" ::: "memory");
    const int c = lane & 7;
#pragma unroll
    for (int j = 0; j < 4; ++j) { const int n = (lane >> 3) + 8 * j; const LAS float* s = scr + (8 * c) * 33 + n;
        u32x4 o; o.x = pk2h(s[0 * 33], s[1 * 33]); o.y = pk2h(s[2 * 33], s[3 * 33]); o.z = pk2h(s[4 * 33], s[5 * 33]); o.w = pk2h(s[6 * 33], s[7 * 33]);
        *(u32x4*)(WT + (size_t)(row0 + n0 + n) * ldd + k0 + 8 * c) = o; }
    asm volatile("s_waitcnt lgkmcnt(0)" ::: "memory");
}

template <bool OUT16> __device__ __forceinline__ void ln_row(const float* xrow, const float* g, const float* b, void* orow, int lane) {
    const f32x4* xr = (const f32x4*)xrow + lane;
    f32x4 v[4]; float s = 0.f;
#pragma unroll
    for (int j = 0; j < 4; ++j) { v[j] = xr[64 * j]; s += (v[j].x + v[j].y) + (v[j].z + v[j].w); }
    const float mean = wave_sum(s) * (1.f / D); float s2 = 0.f;
#pragma unroll
    for (int j = 0; j < 4; ++j) { v[j] = v[j] - mean; s2 += (v[j].x * v[j].x + v[j].y * v[j].y) + (v[j].z * v[j].z + v[j].w * v[j].w); }
    const float rstd = 1.f / sqrtf(wave_sum(s2) * (1.f / D) + LN_EPS);
#pragma unroll
    for (int j = 0; j < 4; ++j) { const f32x4 gg = ((const f32x4*)g)[lane + 64 * j], bb = ((const f32x4*)b)[lane + 64 * j]; const f32x4 o = v[j] * rstd * gg + bb;
        if (OUT16) { u32x2 w; w.x = pk2h(o.x, o.y); w.y = pk2h(o.z, o.w); ((u32x2*)orow)[lane + 64 * j] = w; }
        else ((f32x4*)orow)[lane + 64 * j] = o; }
}

__device__ __forceinline__ unsigned mono_key(float f) { unsigned b = __float_as_uint(f); if (b == 0x80000000u) b = 0u; return b ^ ((unsigned)((int)b >> 31) | 0x80000000u); }
__device__ __forceinline__ int wave_sum_dpp(int c) {
    int x = c;
    x += __builtin_amdgcn_update_dpp(0, x, 0x111, 0xf, 0xf, false);
    x += __builtin_amdgcn_update_dpp(0, x, 0x112, 0xf, 0xf, false);
    x += __builtin_amdgcn_update_dpp(0, x, 0x114, 0xf, 0xf, false);
    x += __builtin_amdgcn_update_dpp(0, x, 0x118, 0xf, 0xf, false);
    x += __builtin_amdgcn_update_dpp(0, x, 0x142, 0xa, 0xf, false);
    x += __builtin_amdgcn_update_dpp(0, x, 0x143, 0xc, 0xf, false);
    return __builtin_amdgcn_readlane(x, 63);
}
__device__ __forceinline__ int count_ge(const unsigned (&u)[64], unsigned cand, int ngrp) {
    int c = 0;
#pragma unroll
    for (int gq = 0; gq < 4; ++gq) if (gq < ngrp) {
#pragma unroll
        for (int jj = 0; jj < 16; ++jj) c += (u[gq * 16 + jj] >= cand) ? 1 : 0; }
    return wave_sum_dpp(c);
}
__device__ __forceinline__ int select_topk(const unsigned (&u)[64], int n, int ngrp, LAS unsigned short* idx, int lane) {
    unsigned th = 0u; int need = 0;
    if (n > 256) {
        unsigned lo = 0u; bool exact = false;
        for (int bit = 31; bit >= 0; --bit) {
            const unsigned cand = lo | (1u << bit); const int c = count_ge(u, cand, ngrp);
            if (c == 256) { th = cand - 1u; need = 0; exact = true; break; }
            if (c > 256) lo = cand;
        }
        if (!exact) { th = lo; need = 256 - count_ge(u, lo + 1u, ngrp); }
    }
    int base = 0, tie_seen = 0;
    const unsigned long long lt = (1ull << lane) - 1ull;
#pragma unroll
    for (int gq = 0; gq < 4; ++gq) if (gq < ngrp) {
#pragma unroll
        for (int jj = 0; jj < 16; ++jj) {
            const int j = gq * 16 + jj;
            const bool gt = u[j] > th; const bool eq = (need > 0) && (u[j] == th);
            const unsigned long long meq = __ballot(eq);
            const int eq_rank = tie_seen + __popcll(meq & lt);
            const bool sel = gt || (eq && eq_rank < need);
            const unsigned long long msel = __ballot(sel);
            const int pos = base + __popcll(msel & lt);
            if (sel) idx[pos] = (unsigned short)(64 * j + lane);
            base += __popcll(msel); tie_seen += __popcll(meq);
        } }
    return base;
}

#define XB_TMO      128
#define XB_XCNT(j)  (256  + 64 * (j))
#define XB_XSUB(j)  (1280 + 64 * (j))
#define XB_XGEN(j)  (2304 + 64 * (j))
#define XB_TOP      3328
#define XB_TOPGEN   3392
#define XCD_BAR_WORDS 3456
#define XB_SPIN_CAP (1u << 18)

__device__ __forceinline__ unsigned xb_ld(unsigned* p)              { return __hip_atomic_load(p, __ATOMIC_RELAXED, __HIP_MEMORY_SCOPE_AGENT); }
__device__ __forceinline__ unsigned xb_add(unsigned* p, unsigned v) { return __hip_atomic_fetch_add(p, v, __ATOMIC_RELAXED, __HIP_MEMORY_SCOPE_AGENT); }
__device__ __forceinline__ unsigned xb_xcc_id() { return (unsigned)__builtin_amdgcn_s_getreg((3 << 11) | 20) & 0xFu; }
#define XB_SPIN(cond, bar) do { unsigned _sp = 0; while (cond) { __builtin_amdgcn_s_sleep(1); \
    if ((++_sp & 255u) == 0u) { if (xb_ld(&(bar)[XB_TMO])) break; if (_sp > XB_SPIN_CAP) { atomicAdd(&(bar)[XB_TMO], 1u); break; } } } } while (0)

struct XcdBarrier {
    unsigned* bar; unsigned x;
    volatile LAS unsigned* st;
};

__device__ __forceinline__ XcdBarrier xcd_barrier_post(unsigned* bar, volatile LAS unsigned* st) {
    XcdBarrier b; b.bar = bar; b.x = xb_xcc_id(); b.st = st;
    if (threadIdx.x == 0) (void)xb_add(&bar[XB_XCNT(b.x)], 1u);
    return b;
}
__device__ __forceinline__ void xcd_barrier_complete(unsigned* bar, unsigned x, unsigned& nloc, unsigned& nx) {
    const unsigned G = gridDim.x * gridDim.y * gridDim.z;
    unsigned sum, cnt, mine, sp = 0u;
    for (;;) {
        sum = 0u; cnt = 0u; mine = 0u;
#pragma unroll
        for (unsigned j = 0; j < 16; ++j) { const unsigned c = xb_ld(&bar[XB_XCNT(j)]); sum += c; cnt += (c > 0u) ? 1u : 0u; mine = (j == x) ? c : mine; }
        if (sum == G) break;
        __builtin_amdgcn_s_sleep(1);
        if ((++sp & 255u) == 0u) { if (xb_ld(&bar[XB_TMO])) break; if (sp > XB_SPIN_CAP) { atomicAdd(&bar[XB_TMO], 1u); break; } }
    }
    nloc = mine > 0u ? mine : 1u; nx = cnt > 0u ? cnt : 1u;
}

__device__ __forceinline__ void xcd_barrier(const XcdBarrier& b) {
    asm volatile("s_waitcnt vmcnt(0)" ::: "memory");
    __syncthreads();
    if (threadIdx.x == 0) {
        unsigned* bar = b.bar;
        __builtin_amdgcn_s_waitcnt(0);
        unsigned nloc = b.st[0], nx = b.st[1];
        if (nloc == 0u) { xcd_barrier_complete(bar, b.x, nloc, nx); b.st[0] = nloc; b.st[1] = nx; }
        const unsigned old = xb_add(&bar[XB_XSUB(b.x)], 1u);
        const unsigned gen = old / nloc;
        if (old + 1u == (gen + 1u) * nloc) {
            __builtin_amdgcn_fence(__ATOMIC_RELEASE, "agent");
            asm volatile("s_waitcnt vmcnt(0)" ::: "memory");
            const unsigned og = xb_add(&bar[XB_TOP], 1u);
            const unsigned tg = og / nx;
            if (og + 1u == (tg + 1u) * nx) xb_add(&bar[XB_TOPGEN], 1u);
            else XB_SPIN(xb_ld(&bar[XB_TOPGEN]) == tg, bar);
            __builtin_amdgcn_fence(__ATOMIC_ACQUIRE, "agent");
            xb_add(&bar[XB_XGEN(b.x)], 1u);
            asm volatile("s_waitcnt vmcnt(0)" ::: "memory");
        } else {
            XB_SPIN(xb_ld(&bar[XB_XGEN(b.x)]) == gen, bar);
            __builtin_amdgcn_fence(__ATOMIC_ACQUIRE, "agent");
            asm volatile("s_waitcnt vmcnt(0)" ::: "memory");
        }
    }
    __syncthreads();
}

#ifndef PHM
#define PHM 0xFFFF
#endif
constexpr int NWAVES = 8, NTHREADS = 512;
constexpr int LDS_BYTES = 147456;

__global__ void __launch_bounds__(NTHREADS, 2) fwd_kernel(Params p) {
    extern __shared__ __attribute__((aligned(16))) unsigned char lds_raw[];
    LAS unsigned char* lds = (LAS unsigned char*)lds_raw;
    int tid = threadIdx.x, lane = tid & 63; const int wave = __builtin_amdgcn_readfirstlane(tid >> 6);
    volatile LAS unsigned* MISC = (volatile LAS unsigned*)(lds + LDS_BYTES - 256);
    if (tid < 64) MISC[tid] = 0u;
    __syncthreads();
    const XcdBarrier xbar = xcd_barrier_post((unsigned*)(p.ws + WS_CTL) + 4096, MISC + 8);
#define GSYNC() do { xcd_barrier(xbar); asm volatile("" : "+v"(lane), "+v"(tid)); } while (0)
    const int G = gridDim.x, gw = blockIdx.x * NWAVES + wave, NGW = G * NWAVES;
    unsigned char* ws = p.ws;
    float* RELB = (float*)(ws + WS_RELB); float* BINP = (float*)(ws + WS_BINP);
    h16* BT_IN = (h16*)(ws + WS_BT_IN); h16* BT_O = (h16*)(ws + WS_BT_O); h16* BT_Q = (h16*)(ws + WS_BT_Q); h16* BT_KV = (h16*)(ws + WS_BT_KV);
    h16* BT_WO = (h16*)(ws + WS_BT_WO); h16* BT_UP = (h16*)(ws + WS_BT_UP); h16* BT_DN = (h16*)(ws + WS_BT_DN);
    h16* MEM16 = (h16*)(ws + WS_MEM16); h16* KM = (h16*)(ws + WS_KVM); h16* VT = (h16*)(ws + WS_KVM + 4 * MiB); h16* X16 = (h16*)(ws + WS_X16); h16* MIX = (h16*)(ws + WS_MIX); h16* H = (h16*)(ws + WS_H);
    float* RAW = (float*)(ws + WS_RAW); h16* CB = (h16*)(ws + WS_CB); h16* IK16 = (h16*)(ws + WS_IK); float* IW = (float*)(ws + WS_IW); float* SCR = (float*)(ws + WS_SCR);
    h16* Q2 = (h16*)(ws + WS_Q2); h16* O2 = (h16*)(ws + WS_O2); h16* HFF = (h16*)(ws + WS_HFF);
    float* PRE = p.out;

    if (PHM & 1) {
        LAS float* scr = (LAS float*)(lds + wave * 16384);
        const float* W_IN = p.in[I_W_IN];
        constexpr int J0 = 16 * 16, J1 = 16 * 8, J2 = 16 * 4, J3 = 16 * 2, J4 = 16 * 16, J5 = 8 * 32, J6 = 16 * 32, J7 = 16 * 64, J8 = 16 * 32, J9 = 16 * 128, J10 = 64 * 32;
        constexpr int NIT = J0 + J1 + J2 + J3 + J4 + J5 + J6 + J7 + J8 + J9 + J10;
        for (int it = gw; it < NIT; it += NGW) {
            int r = it;
            if (r < J0) { p0_transpose_item(W_IN, DIN, 0, BT_IN, D, 0, 16, scr, r, lane); continue; } r -= J0;
            if (r < J1) { p0_transpose_item(W_IN, DIN, 512, BT_IN, D, 512, 8, scr, r, lane); continue; } r -= J1;
            if (r < J2) { p0_transpose_item(W_IN, DIN, 1280, BT_IN, D, 1792, 4, scr, r, lane); continue; } r -= J2;
            if (r < J3) { p0_transpose_item(W_IN, DIN, 1920, BT_IN, D, 1920, 2, scr, r, lane); continue; } r -= J3;
            if (r < J4) { p0_transpose_item(W_IN, DIN, 1408, BT_IN, D, 2048, 16, scr, r, lane); continue; } r -= J4;
            if (r < J5) { p0_transpose_item(p.in[I_W_O], D, 0, BT_O, MIXK, 0, 32, scr, r, lane); continue; } r -= J5;
            if (r < J6) { p0_transpose_item(p.in[I_WQ], D, 0, BT_Q, D, 0, 32, scr, r, lane); continue; } r -= J6;
            if (r < J7) { p0_transpose_item(p.in[I_WKV], 2 * D, 0, BT_KV, D, 0, 64, scr, r, lane); continue; } r -= J7;
            if (r < J8) { p0_transpose_item(p.in[I_WO], D, 0, BT_WO, D, 0, 32, scr, r, lane); continue; } r -= J8;
            if (r < J9) { p0_transpose_item(p.in[I_W_UP], FF, 0, BT_UP, D, 0, 128, scr, r, lane); continue; } r -= J9;
            p0_transpose_item(p.in[I_W_DN], D, 0, BT_DN, FF, 0, 32, scr, r, lane);
        }
        const float* WUK = p.in[I_W_UK]; const float* WUV = p.in[I_W_UV]; const float* W_O = p.in[I_W_O];
        for (int it = gw; it < 4096; it += NGW) {
            const int h = it >> 9, kt = (it >> 5) & 15, cs = it & 31, k = 64 * kt + lane;
            const f32x4* wr = (const f32x4*)(W_IN + (size_t)k * DIN + 768 + 64 * h);
            f32x4 w[16];
#pragma unroll
            for (int i = 0; i < 16; ++i) w[i] = wr[i];
#pragma unroll
            for (int ci = 0; ci < 4; ++ci) {
                const int n = h * 128 + 4 * cs + ci; const f32x4* ur = (const f32x4*)(WUK + (size_t)n * 64);
                float a = 0.f;
#pragma unroll
                for (int i = 0; i < 16; ++i) { const f32x4 uu = ur[i]; a += w[i].x * uu.x + w[i].y * uu.y + w[i].z * uu.z + w[i].w * uu.w; }
                ((f16*)BT_IN)[(size_t)(768 + n) * D + k] = (f16)(a * 0.125f);
            }
        }
        for (int it = gw; it < 4096; it += NGW) {
            const int h = it >> 9, nt = (it >> 5) & 15, cs = it & 31, n = 64 * nt + lane;
            float w[64];
#pragma unroll
            for (int d = 0; d < 64; ++d) w[d] = W_O[(size_t)(512 + 64 * h + d) * D + n];
#pragma unroll
            for (int ci = 0; ci < 4; ++ci) {
                const int j = h * 128 + 4 * cs + ci; const f32x4* vr = (const f32x4*)(WUV + (size_t)j * 64);
                float a = 0.f;
#pragma unroll
                for (int i = 0; i < 16; ++i) { const f32x4 vv = vr[i]; a += w[4 * i] * vv.x + w[4 * i + 1] * vv.y + w[4 * i + 2] * vv.z + w[4 * i + 3] * vv.w; }
                ((f16*)BT_O)[(size_t)n * MIXK + 512 + j] = (f16)a;
            }
        }
        for (int it = gw; it < 64 * 16; it += NGW) {
            const int r = it >> 4, k = ((it & 15) << 6) + lane;
            const float v = (r < 8) ? W_IN[(size_t)k * DIN + 1984 + r] : 0.f;
            ((f16*)BT_IN)[(size_t)(1984 + r) * D + k] = (f16)v;
        }
        const float* B_IN = p.in[I_B_IN];
        for (int n = gw * 64 + lane; n < NIN; n += NGW * 64) {
            float v;
            if (n < 768) v = B_IN[n];
            else if (n < 1792) { const int j = n - 768, h = j >> 7; float a = 0.f; for (int d = 0; d < 64; ++d) a += B_IN[768 + 64 * h + d] * WUK[(size_t)j * 64 + d]; v = a * 0.125f; }
            else if (n < 1920) v = B_IN[1280 + (n - 1792)];
            else if (n < 1992) v = B_IN[n];
            else if (n < 2048) v = 0.f;
            else v = B_IN[1408 + (n - 2048)];
            BINP[n] = v;
        }
        const float* REL = p.in[I_REL];
        for (int i = gw * 64 + lane; i < 16 * 132; i += NGW * 64) { const int h = i / 132, d = i % 132; RELB[i] = REL[(int)REL_BUCKET[d > 128 ? 128 : d] * 16 + h]; }
        const float* MEMF = p.in[I_MEM];
        for (int i = gw * 64 + lane; i < MROWS * D / 4; i += NGW * 64) { const f32x4 v = ((const f32x4*)MEMF)[i]; u32x2 w; w.x = pk2h(v.x, v.y); w.y = pk2h(v.z, v.w); ((u32x2*)MEM16)[i] = w; }
        for (int m = gw; m < M; m += NGW) ln_row<true>(p.in[I_X] + (size_t)m * D, p.in[I_LNE_G], p.in[I_LNE_B], X16 + (size_t)m * D, lane);
    }
    GSYNC();

    if (PHM & 2) {
        pg8::Gemm g{X16, BT_IN, M, NIN, D}; pg8::StaticOrder S; S.init(M, NIN, G, (int)blockIdx.x);
        pg8::EpiIn E{H, NIN, BINP, RAW, RAWT};
        pg8::gemm_phase<pg8::EpiIn, pg8::StaticOrder, true, true>(lds, g, S, E);
    }
    if (PHM & 4) {
        pg8::Gemm g{MEM16, BT_KV, MROWS, 2 * D, D}; pg8::StaticOrder S; S.init(MROWS, 2 * D, G, (int)blockIdx.x);
        pg8::EpiKV E{KM, VT, p.in[I_BKV]};
        pg8::gemm_phase<pg8::EpiKV, pg8::StaticOrder, true, true>(lds, g, S, E);
    }
    GSYNC();

    if (PHM & 8) {
        const float* KG = p.in[I_KVN_G]; const float* IG = p.in[I_IKLN_G]; const float* IB = p.in[I_IKLN_B];
        for (int m = gw; m < M; m += NGW) {
            const float* r = RAW + (size_t)m * 256;
            const float c0 = r[lane], c1 = r[64 + lane];
            const float rr = 1.f / sqrtf(wave_sum(c0 * c0 + c1 * c1) * (1.f / 128.f) + LN_EPS);
            ((f16*)CB)[(size_t)m * 128 + lane] = (f16)(c0 * rr * KG[lane]); ((f16*)CB)[(size_t)m * 128 + 64 + lane] = (f16)(c1 * rr * KG[64 + lane]);
            const float k = r[128 + lane]; const float mu = wave_sum(k) * (1.f / 64.f); const float dk = k - mu;
            const float rs = 1.f / sqrtf(wave_sum(dk * dk) * (1.f / 64.f) + LN_EPS);
            ((f16*)IK16)[(size_t)m * 64 + lane] = (f16)(dk * rs * IG[lane] + IB[lane]);
            if (lane < 8) IW[(size_t)m * 8 + lane] = r[192 + lane] * (0.35355339059327373f * 0.125f);
        }
    }
    GSYNC();

    if (PHM & 32) {
        LAS unsigned short* idx_all = (LAS unsigned short*)(lds + 65536);
        LAS float* relb_s = (LAS float*)(lds + 65536 + 16384);
        LAS int* s_item = (LAS int*)(lds + 65536 + 16384 + 4224);
        LAS float* rba_s = (LAS float*)(lds + 86400);
        for (int i = tid; i < 8 * 132; i += NTHREADS) relb_s[i] = RELB[8 * 132 + i];
        for (int i = tid; i < 8 * 128; i += NTHREADS) rba_s[i] = RELB[(i >> 7) * 132 + (i & 127)];
        float* SCRW = SCR + (size_t)blockIdx.x * (32 * 4096);
        unsigned* qctr = (unsigned*)(ws + WS_CTL) + 64;
        for (;;) {
            __syncthreads();
            if (tid == 0) *s_item = (int)atomicAdd(qctr, 1u);
            __syncthreads();
            const int item = *s_item;
            if (item >= NB * 128 + 512) break;
            if (item >= NB * 128) {
                const int unit = item - NB * 128, kvh = unit & 1, n = (unit >> 1) & 31, b = unit >> 6;
                LAS unsigned char* Ks = lds;
                LAS unsigned char* Vt = lds + 32768;
                asm volatile("" : "+v"(lane), "+v"(tid));
#pragma unroll
                for (int i = 0; i < 4; ++i) {
                    const int pz = tid + 512 * i, r = pz >> 3, ch = pz & 7;
                    u32x4 kv = (u32x4){0u, 0u, 0u, 0u}, vv = (u32x4){0u, 0u, 0u, 0u};
                    if (n > 0 || r >= 128) { const f16* src = (const f16*)H + (size_t)(b * T + 128 * (n - 1) + r) * NIN + 512 + kvh * 64 + 8 * ch; kv = *(const u32x4*)src; vv = *(const u32x4*)(src + 128); }
                    *(LAS u32x4*)(Ks + r * 128 + ((ch ^ ((r >> 1) & 7)) << 4)) = kv;
                    LAS unsigned short* vd = (LAS unsigned short*)(Vt + (8 * ch) * 520 + r * 2);
                    vd[0 * 260] = (unsigned short)(vv.x & 0xffffu); vd[1 * 260] = (unsigned short)(vv.x >> 16); vd[2 * 260] = (unsigned short)(vv.y & 0xffffu); vd[3 * 260] = (unsigned short)(vv.y >> 16);
                    vd[4 * 260] = (unsigned short)(vv.z & 0xffffu); vd[5 * 260] = (unsigned short)(vv.z >> 16); vd[6 * 260] = (unsigned short)(vv.w & 0xffffu); vd[7 * 260] = (unsigned short)(vv.w >> 16);
                }
                __syncthreads();
                const int c = lane & 31, hi = lane >> 5, hd = 4 * kvh + (wave & 3), qhalf = wave >> 2;
                const float sink = p.in[I_SINKS][hd];
                const LAS float* rbh = rba_s + hd * 128;
#pragma unroll 1
                for (int sb = 0; sb < 2; ++sb) {
                    const int j0 = 2 * qhalf + sb, q0 = 32 * j0;
                    const size_t mrow = (size_t)(b * T + 128 * n + q0 + c);
                    f16x8 qf[4];
#pragma unroll
                    for (int ks = 0; ks < 4; ++ks) qf[ks] = *(const f16x8*)((const f16*)H + mrow * NIN + hd * 64 + 16 * ks + 8 * hi);
                    f32x16 S[5];
#pragma unroll
                    for (int jt = 0; jt < 5; ++jt) {
#pragma unroll
                        for (int r = 0; r < 16; ++r) S[jt][r] = 0.f;
#pragma unroll
                        for (int ks = 0; ks < 4; ++ks) {
                            const f16x8 a = *(const LAS f16x8*)(Ks + (32 * (j0 + jt) + c) * 128 + (((2 * ks + hi) ^ ((c >> 1) & 7)) << 4));
                            S[jt] = __builtin_amdgcn_mfma_f32_32x32x16_f16(a, qf[ks], S[jt], 0, 0, 0);
                        }
                    }
                    float mx = sink;
#pragma unroll
                    for (int jt = 0; jt < 5; ++jt)
#pragma unroll
                        for (int r = 0; r < 16; ++r) {
                            const int si = 32 * (j0 + jt) + (r & 3) + 8 * (r >> 2) + 4 * hi; const int rel = q0 + c + 128 - si;
                            const bool valid = (rel >= 0) && (rel < 128) && (n > 0 || si >= 128);
                            const float l = valid ? S[jt][r] * 0.125f + rbh[rel & 127] : NEG_INF;
                            S[jt][r] = l; mx = fmaxf(mx, l);
                        }
                    mx = fmaxf(mx, __shfl_xor(mx, 32));
                    float sum = 0.f;
#pragma unroll
                    for (int jt = 0; jt < 5; ++jt)
#pragma unroll
                        for (int r = 0; r < 16; ++r) { const float e = __expf(S[jt][r] - mx); S[jt][r] = e; sum += e; }
                    sum += __shfl_xor(sum, 32);
                    const float inv = 1.f / (sum + __expf(sink - mx));
                    f32x16 o[2];
#pragma unroll
                    for (int dt = 0; dt < 2; ++dt)
#pragma unroll
                        for (int r = 0; r < 16; ++r) o[dt][r] = 0.f;
#pragma unroll
                    for (int jt = 0; jt < 5; ++jt)
#pragma unroll
                        for (int s = 0; s < 2; ++s) {
                            f16x8 pb;
#pragma unroll
                            for (int j = 0; j < 8; ++j) pb[j] = (f16)S[jt][8 * s + j];
#pragma unroll
                            for (int dt = 0; dt < 2; ++dt) {
                                const LAS unsigned char* vp = Vt + (32 * dt + c) * 520 + (32 * (j0 + jt) + 16 * s + 4 * hi) * 2;
                                const f16x4 v0 = *(const LAS f16x4*)vp, v1 = *(const LAS f16x4*)(vp + 16);
                                const f16x8 av = (f16x8){v0[0], v0[1], v0[2], v0[3], v1[0], v1[1], v1[2], v1[3]};
                                o[dt] = __builtin_amdgcn_mfma_f32_32x32x16_f16(av, pb, o[dt], 0, 0, 0);
                            }
                        }
                    f16* op = (f16*)MIX + mrow * MIXK + hd * 64 + 4 * hi;
#pragma unroll
                    for (int dt = 0; dt < 2; ++dt)
#pragma unroll
                        for (int rq = 0; rq < 4; ++rq) { u32x2 w; w.x = pk2h(o[dt][4 * rq] * inv, o[dt][4 * rq + 1] * inv); w.y = pk2h(o[dt][4 * rq + 2] * inv, o[dt][4 * rq + 3] * inv); *(u32x2*)(op + 32 * dt + 8 * rq) = w; }
                }
                continue;
            }
            const int qb32 = 127 - (item >> 3), b = item & 7;
            const int m0 = b * T + 32 * qb32;
            asm volatile("" : "+v"(lane));
            const int c32 = lane & 31, hi = lane >> 5;
            {
                f16x8 bq[8][4];
                const f16* iqp = (const f16*)H + (size_t)(m0 + c32) * NIN + 2048 + 8 * hi;
#pragma unroll
                for (int h = 0; h < 8; ++h)
#pragma unroll
                    for (int ks = 0; ks < 4; ++ks) bq[h][ks] = *(const f16x8*)(iqp + h * 64 + ks * 16);
                float iwv[8];
                { const f32x4 w0 = *(const f32x4*)(IW + (size_t)(m0 + c32) * 8), w1 = *(const f32x4*)(IW + (size_t)(m0 + c32) * 8 + 4);
                  iwv[0] = w0.x; iwv[1] = w0.y; iwv[2] = w0.z; iwv[3] = w0.w; iwv[4] = w1.x; iwv[5] = w1.y; iwv[6] = w1.z; iwv[7] = w1.w; }
                for (int kt = wave; kt <= qb32; kt += 8) {
                    const f16* ikp = (const f16*)IK16 + (size_t)(b * T + kt * 32 + c32) * 64 + 8 * hi;
                    f16x8 ak[4];
#pragma unroll
                    for (int ks = 0; ks < 4; ++ks) ak[ks] = *(const f16x8*)(ikp + ks * 16);
                    float sc[16];
#pragma unroll
                    for (int r = 0; r < 16; ++r) sc[r] = 0.f;
#pragma unroll
                    for (int h = 0; h < 8; ++h) {
                        f32x16 acc;
#pragma unroll
                        for (int r = 0; r < 16; ++r) acc[r] = 0.f;
#pragma unroll
                        for (int ks = 0; ks < 4; ++ks) acc = __builtin_amdgcn_mfma_f32_32x32x16_f16(ak[ks], bq[h][ks], acc, 0, 0, 0);
#pragma unroll
                        for (int r = 0; r < 16; ++r) { const int ai = __float_as_int(acc[r]); sc[r] += iwv[h] * __int_as_float(ai < 0 ? 0 : ai); }
#pragma unroll
                        for (int r = 0; r < 16; ++r) asm volatile("" : "+v"(sc[r]));
                    }
                    float* sp = SCRW + (size_t)c32 * 4096 + kt * 32 + 4 * hi;
#pragma unroll
                    for (int i = 0; i < 4; ++i) *(f32x4*)(sp + 8 * i) = (f32x4){sc[4 * i], sc[4 * i + 1], sc[4 * i + 2], sc[4 * i + 3]};
                }
            }
            asm volatile("s_waitcnt vmcnt(0)" ::: "memory");
            __syncthreads();
#pragma unroll 1
            for (int qi = 0; qi < 4; ++qi) {
                const int q = 4 * wave + qi, t = 32 * qb32 + q, m = m0 + q;
                int lane_o = lane; asm volatile("" : "+v"(lane_o));
                const int head = lane_o & 15, g = lane_o >> 4;
                LAS unsigned char* gb = lds + wave * 8192;
                LAS unsigned short* idxq = idx_all + q * 256;
                int cnt;
                {
                    unsigned u[64];
                    const float* sb = SCRW + (size_t)q * 4096 + lane; asm volatile("" : "+v"(sb));
                    const int ngrp = (t >> 10) + 1;
#pragma unroll
                    for (int gq = 0; gq < 4; ++gq) {
                        if (gq < ngrp) {
#pragma unroll
                            for (int jj = 0; jj < 16; ++jj) { const int j = gq * 16 + jj; u[j] = __float_as_uint(ld_sc1(sb + 64 * j)); }
                        } else {
#pragma unroll
                            for (int jj = 0; jj < 16; ++jj) u[gq * 16 + jj] = 0u;
                        }
                    }
#pragma unroll
                    for (int gq = 0; gq < 4; ++gq) {
                        if (gq < ngrp) {
#pragma unroll
                            for (int jj = 0; jj < 16; ++jj) { const int j = gq * 16 + jj; u[j] = (64 * j + lane <= t) ? mono_key(__uint_as_float(u[j])) : 0u; }
                        }
                    }
                    cnt = select_topk(u, t + 1, ngrp, idxq, lane);
                    for (int e = cnt + lane; e < 256; e += 64) idxq[e] = 0;
                }
                asm volatile("s_waitcnt lgkmcnt(0)" ::: "memory");
                {
                    f16x8 qf[4];
                    { const f16* qp = (const f16*)H + (size_t)m * NIN + 768 + (head & 7) * 128 + 8 * g;
#pragma unroll
                      for (int ks = 0; ks < 4; ++ks) { f16x8 v = *(const f16x8*)(qp + 32 * ks); if (head >= 8) v = (f16x8){0, 0, 0, 0, 0, 0, 0, 0}; qf[ks] = v; } }
                    const f16* cbb = (const f16*)CB + (size_t)(b * T) * 128 + (lane_o & 15) * 8;
                    u32x4 gr[2][8];
#pragma unroll
                    for (int hf = 0; hf < 2; ++hf)
#pragma unroll
                        for (int i = 0; i < 8; ++i) { const int s = (int)idxq[hf * 32 + 4 * i + g]; gr[hf][i] = *(const u32x4*)(cbb + (size_t)s * 128); }
                    float m_run = -3.0e38f, l_part = 0.f;
                    f32x4 o[8];
#pragma unroll
                    for (int ct = 0; ct < 8; ++ct) o[ct] = (f32x4){0.f, 0.f, 0.f, 0.f};
                    const int rowA0 = 8 * ((lane_o & 15) >> 2) + (lane_o & 3);
                    const LAS float* rbh = relb_s + (head & 7) * 132;
#pragma unroll 1
                    for (int cp = 0; cp < 4; ++cp) {
#pragma unroll
                      for (int hf = 0; hf < 2; ++hf) {
                        const int chunk = 2 * cp + hf;
#pragma unroll
                        for (int i = 0; i < 8; ++i) *(LAS u32x4*)(gb + off_b(4 * i + g, lane_o & 15)) = gr[hf][i];
                        if (cp < 3) {
#pragma unroll
                            for (int i = 0; i < 8; ++i) { const int s = (int)idxq[(chunk + 2) * 32 + 4 * i + g]; gr[hf][i] = *(const u32x4*)(cbb + (size_t)s * 128); }
                        }
                        f32x4 S0 = (f32x4){0.f, 0.f, 0.f, 0.f}, S1 = (f32x4){0.f, 0.f, 0.f, 0.f};
#pragma unroll
                        for (int ks = 0; ks < 4; ++ks) {
                            const f16x8 a0 = *(const LAS f16x8*)(gb + off_b(rowA0, 4 * ks + g)), a1 = *(const LAS f16x8*)(gb + off_b(rowA0 + 4, 4 * ks + g));
                            S0 = __builtin_amdgcn_mfma_f32_16x16x32_f16(a0, qf[ks], S0, 0, 0, 0);
                            S1 = __builtin_amdgcn_mfma_f32_16x16x32_f16(a1, qf[ks], S1, 0, 0, 0);
                        }
                        const u16x8 myi = *(const LAS u16x8*)(idxq + chunk * 32 + 8 * g);
                        float lg[8];
#pragma unroll
                        for (int j = 0; j < 8; ++j) { const int s = (int)myi[j]; int dist = t - s; dist = dist > 128 ? 128 : dist; const float sv = (j < 4) ? S0[j & 3] : S1[j & 3];
                            lg[j] = (chunk * 32 + 8 * g + j < cnt) ? sv + rbh[dist] : NEG_INF; }
                        float mx = fmaxf(fmaxf(fmaxf(lg[0], lg[1]), fmaxf(lg[2], lg[3])), fmaxf(fmaxf(lg[4], lg[5]), fmaxf(lg[6], lg[7])));
                        mx = fmaxf(mx, __shfl_xor(mx, 16)); mx = fmaxf(mx, __shfl_xor(mx, 32));
                        const float m_new = fmaxf(m_run, mx); const float scl = __expf(m_run - m_new); m_run = m_new;
                        float pr[8]; float ps = 0.f;
#pragma unroll
                        for (int j = 0; j < 8; ++j) { pr[j] = __expf(lg[j] - m_new); ps += pr[j]; }
                        l_part = l_part * scl + ps;
                        f16x8 pb;
#pragma unroll
                        for (int j = 0; j < 8; ++j) pb[j] = (f16)pr[j];
#pragma unroll
                        for (int ct = 0; ct < 8; ++ct) {
                            const v4i16 t0 = __builtin_amdgcn_ds_read_tr16_b64_v4i16((LAS v4i16*)(gb + tr_addr16(lane_o, ct, 0)));
                            const v4i16 t1 = __builtin_amdgcn_ds_read_tr16_b64_v4i16((LAS v4i16*)(gb + tr_addr16(lane_o, ct, 1)));
                            const v8i16 av = (v8i16){t0[0], t0[1], t0[2], t0[3], t1[0], t1[1], t1[2], t1[3]};
                            o[ct] = o[ct] * scl;
                            o[ct] = __builtin_amdgcn_mfma_f32_16x16x32_f16(__builtin_bit_cast(f16x8, av), pb, o[ct], 0, 0, 0);
                        }
                      }
                    }
                    float l_tot = l_part; l_tot += __shfl_xor(l_tot, 16); l_tot += __shfl_xor(l_tot, 32);
                    const float inv = 1.f / l_tot;
                    if (head < 8) {
                        f16* op = (f16*)MIX + (size_t)m * MIXK + 512 + head * 128 + 4 * g;
#pragma unroll
                        for (int ct = 0; ct < 8; ++ct) { u32x2 w; w.x = pk2h(o[ct][0] * inv, o[ct][1] * inv); w.y = pk2h(o[ct][2] * inv, o[ct][3] * inv); *(u32x2*)(op + 16 * ct) = w; }
                    }
                }
            }
        }
    }
    GSYNC();

    if (PHM & 64) {
        pg8::Gemm g{MIX, BT_O, M, D, MIXK}; pg8::StaticOrder S; S.init(M, D, G, (int)blockIdx.x);
        pg8::EpiPre E{X16, PRE, D, p.in[I_B_O], DN_ALPHA};
        pg8::gemm_phase<pg8::EpiPre, pg8::StaticOrder, true, true>(lds, g, S, E);
    }
    GSYNC();
    for (int m = gw; m < M; m += NGW) ln_row<true>(PRE + (size_t)m * D, p.in[I_LN1_G], p.in[I_LN1_B], X16 + (size_t)m * D, lane);
    GSYNC();

    if (PHM & 128) {
        pg8::Gemm g{X16, BT_Q, M, D, D}; pg8::StaticOrder S; S.init(M, D, G, (int)blockIdx.x);
        pg8::EpiF16<0> E{Q2, D, p.in[I_BQ]};
        pg8::gemm_phase<pg8::EpiF16<0>, pg8::StaticOrder, true, true>(lds, g, S, E);
    }
    GSYNC();

    if (PHM & 256) {
        LAS unsigned char* Ks = lds;
        LAS unsigned char* Vs = lds + 32768;
        const int q16 = lane & 15, g = lane >> 4;
        for (int unit = blockIdx.x; unit < 1024; unit += G) {
            const int qblk = unit & 31, head = (unit >> 5) & 3, b = unit >> 7;
            const size_t mrow = (size_t)b * T + qblk * 128 + wave * 16 + q16;
            f16x8 qf[8];
#pragma unroll
            for (int ks = 0; ks < 8; ++ks) qf[ks] = *(const f16x8*)((const f16*)Q2 + mrow * D + head * 256 + 32 * ks + 8 * g);
            f32x4 o[16];
#pragma unroll
            for (int dt = 0; dt < 16; ++dt) o[dt] = (f32x4){0.f, 0.f, 0.f, 0.f};
            float m_run = -3.0e38f, l_part = 0.f;
#pragma unroll 1
            for (int c = 0; c < 4; ++c) {
                __syncthreads();
#pragma unroll
                for (int i = 0; i < 4; ++i) {
                    const int pz = tid + 512 * i;
                    { const int r = pz >> 5, ch = pz & 31;
                      const u32x4 v = *(const u32x4*)((const f16*)KM + (size_t)(b * MEML + 64 * c + r) * D + head * 256 + 8 * ch);
                      *(LAS u32x4*)(Ks + r * 512 + ((ch ^ (r & 15)) << 4)) = v; }
                    { const int d = pz >> 3, pc = pz & 7;
                      const u32x4 v = *(const u32x4*)((const f16*)VT + (size_t)((b * 4 + head) * 256 + d) * MEML + 64 * c + 8 * pc);
                      *(LAS u32x4*)(Vs + d * 144 + pc * 16) = v; }
                }
                __syncthreads();
                f32x4 S[4];
#pragma unroll
                for (int u = 0; u < 4; ++u) {
                    S[u] = (f32x4){0.f, 0.f, 0.f, 0.f};
#pragma unroll
                    for (int ks = 0; ks < 8; ++ks) {
                        const f16x8 a = *(const LAS f16x8*)(Ks + (16 * u + q16) * 512 + (((4 * ks + g) ^ q16) << 4));
                        S[u] = __builtin_amdgcn_mfma_f32_16x16x32_f16(a, qf[ks], S[u], 0, 0, 0);
                    }
                }
                float mx = -3.0e38f;
#pragma unroll
                for (int u = 0; u < 4; ++u)
#pragma unroll
                    for (int r = 0; r < 4; ++r) { S[u][r] *= 0.0625f; mx = fmaxf(mx, S[u][r]); }
                mx = fmaxf(mx, __shfl_xor(mx, 16)); mx = fmaxf(mx, __shfl_xor(mx, 32));
                const float m_new = fmaxf(m_run, mx); const float scl = __expf(m_run - m_new); m_run = m_new;
                float ps = 0.f;
#pragma unroll
                for (int u = 0; u < 4; ++u)
#pragma unroll
                    for (int r = 0; r < 4; ++r) { S[u][r] = __expf(S[u][r] - m_new); ps += S[u][r]; }
                l_part = l_part * scl + ps;
                f16x8 pb[2];
#pragma unroll
                for (int v = 0; v < 2; ++v)
#pragma unroll
                    for (int j = 0; j < 4; ++j) { pb[v][j] = (f16)S[2 * v][j]; pb[v][4 + j] = (f16)S[2 * v + 1][j]; }
#pragma unroll
                for (int dt = 0; dt < 16; ++dt) {
                    o[dt] = o[dt] * scl;
#pragma unroll
                    for (int v = 0; v < 2; ++v) {
                        const LAS unsigned char* vp = Vs + (16 * dt + q16) * 144 + (32 * v + 4 * g) * 2;
                        const f16x4 v0 = *(const LAS f16x4*)vp, v1 = *(const LAS f16x4*)(vp + 32);
                        const f16x8 av = (f16x8){v0[0], v0[1], v0[2], v0[3], v1[0], v1[1], v1[2], v1[3]};
                        o[dt] = __builtin_amdgcn_mfma_f32_16x16x32_f16(av, pb[v], o[dt], 0, 0, 0);
                    }
                }
            }
            float l_tot = l_part; l_tot += __shfl_xor(l_tot, 16); l_tot += __shfl_xor(l_tot, 32);
            const float inv = 1.f / l_tot;
            f16* op = (f16*)O2 + mrow * D + head * 256 + 4 * g;
#pragma unroll
            for (int dt = 0; dt < 16; ++dt) { u32x2 w; w.x = pk2h(o[dt][0] * inv, o[dt][1] * inv); w.y = pk2h(o[dt][2] * inv, o[dt][3] * inv); *(u32x2*)(op + 16 * dt) = w; }
        }
    }
    GSYNC();

    if (PHM & 512) {
        pg8::Gemm g{O2, BT_WO, M, D, D}; pg8::StaticOrder S; S.init(M, D, G, (int)blockIdx.x);
        pg8::EpiPre E{X16, PRE, D, p.in[I_BO], DN_ALPHA};
        pg8::gemm_phase<pg8::EpiPre, pg8::StaticOrder, true, true>(lds, g, S, E);
    }
    GSYNC();
    for (int m = gw; m < M; m += NGW) ln_row<true>(PRE + (size_t)m * D, p.in[I_LN2_G], p.in[I_LN2_B], X16 + (size_t)m * D, lane);
    GSYNC();

    if (PHM & 1024) {
        pg8::Gemm g{X16, BT_UP, M, FF, D}; pg8::StaticOrder S; S.init(M, FF, G, (int)blockIdx.x);
        pg8::EpiF16<2> E{HFF, FF, p.in[I_B_UP]};
        pg8::gemm_phase<pg8::EpiF16<2>, pg8::StaticOrder, true, true>(lds, g, S, E);
    }
    GSYNC();
    if (PHM & 2048) {
        pg8::Gemm g{HFF, BT_DN, M, D, FF}; pg8::StaticOrder S; S.init(M, D, G, (int)blockIdx.x);
        pg8::EpiPre E{X16, PRE, D, p.in[I_B_DN], DN_ALPHA};
        pg8::gemm_phase<pg8::EpiPre, pg8::StaticOrder, true, true>(lds, g, S, E);
    }
    GSYNC();
    for (int m = gw; m < M; m += NGW) ln_row<false>(PRE + (size_t)m * D, p.in[I_LN3_G], p.in[I_LN3_B], p.out + (size_t)m * D, lane);
}

extern "C" void kernel_launch(void* const* d_in, const int* in_sizes, int n_in, void* d_out, int out_size, void* d_ws, size_t ws_size, hipStream_t stream) {
    static int grid = 0;
    if (grid == 0) {
        if (n_in != 31 || out_size != M * D || ws_size < WS_END) { fprintf(stderr, "kernel_launch: unexpected shapes (n_in %d, out %d, ws %zu)\n", n_in, out_size, ws_size); grid = -1; return; }
        int dev = 0, cus = 0, per_cu = 0;
        hipGetDevice(&dev); hipDeviceGetAttribute(&cus, hipDeviceAttributeMultiprocessorCount, dev);
        hipFuncSetAttribute((const void*)fwd_kernel, hipFuncAttributeMaxDynamicSharedMemorySize, LDS_BYTES);
        hipOccupancyMaxActiveBlocksPerMultiprocessor(&per_cu, (const void*)fwd_kernel, NTHREADS, LDS_BYTES);
        if (per_cu < 1) { fprintf(stderr, "kernel_launch: occupancy query says %d blocks per CU\n", per_cu); grid = -1; return; }
        grid = cus;
    }
    if (grid < 0) return;
    hipMemsetAsync((char*)d_ws + WS_CTL, 0, CTL_BYTES, stream);
    Params p{};
    for (int i = 0; i < 31; ++i) p.in[i] = (const float*)d_in[i];
    p.out = (float*)d_out; p.ws = (unsigned char*)d_ws;
    void* args[] = {&p};
    hipError_t e = hipLaunchCooperativeKernel((const void*)fwd_kernel, dim3(grid), dim3(NTHREADS), args, LDS_BYTES, stream);
    if (e != hipSuccess) fprintf(stderr, "cooperative launch failed: %s (grid %d)\n", hipGetErrorString(e), grid);
}
```
